# Optimizing an MI355X kernel written in HIP

```python
import jax, jax.numpy as jnp
from jax import lax
import numpy as np

D_MODEL = 1024
BATCH = 8
SEQ = 4096
DEPTH = 4

MIX_WIDTH = D_MODEL
HEAD_DIM = 64
NSA_WIDTH = MIX_WIDTH // 2
NSA_HEADS = NSA_WIDTH // HEAD_DIM
NSA_KV_GROUPS = 2
HEADS_PER_GROUP = NSA_HEADS // NSA_KV_GROUPS
KV_WIDTH = NSA_KV_GROUPS * HEAD_DIM
CMP_BLOCK = 32
CMP_STRIDE = 16
CMP_HIDDEN = 128
SEL_BLOCK = 64
N_SEL = 8
WINDOW = 512
Q_BLOCK = 128
POOL_WIDTHS = (2, 4, 8, 16)
POOL_CH = MIX_WIDTH - NSA_WIDTH
POOL_GROUP = POOL_CH // len(POOL_WIDTHS)
N_GATES = 3 * NSA_HEADS
IN_SPLITS = (NSA_WIDTH, KV_WIDTH, KV_WIDTH, KV_WIDTH, KV_WIDTH, KV_WIDTH, KV_WIDTH, N_GATES, POOL_CH)
IN_WIDTH = sum(IN_SPLITS)
D_FF = 2816
EPS = 1e-6

kernel_name = "hymba_style_nsa_pool_macaron"


def rms_norm(x, g):
    xf = x.astype(jnp.float32)
    y = xf * lax.rsqrt(jnp.mean(xf * xf, axis=-1, keepdims=True) + EPS)
    return (y * g.astype(jnp.float32)).astype(x.dtype)


def swiglu(h, wg, wu, wd):
    return (jax.nn.silu(h @ wg) * (h @ wu)) @ wd


def alibi_slopes(n):
    return (2.0 ** (-8.0 * np.arange(1, n + 1) / n)).astype(np.float32)


def masked_softmax(s, mask, axis=-1):
    s = jnp.where(mask, s.astype(jnp.float32), -jnp.inf)
    m = jnp.max(s, axis=axis, keepdims=True)
    m = jnp.where(jnp.isfinite(m), m, 0.0)
    p = jnp.exp(s - m)
    return p / jnp.maximum(jnp.sum(p, axis=axis, keepdims=True), 1e-30)


def compress(kv, pe, w1, w2):
    T = kv.shape[2]
    n_cmp = (T - CMP_BLOCK) // CMP_STRIDE + 1
    idx = np.arange(n_cmp)[:, None] * CMP_STRIDE + np.arange(CMP_BLOCK)[None, :]
    blocks = kv[:, :, idx] + pe
    flat = blocks.reshape(blocks.shape[:3] + (CMP_BLOCK * HEAD_DIM,))
    return jax.nn.gelu(flat @ w1) @ w2


def nsa_mixer(q, k_c, v_c, k_s, v_s, k_w, v_w, gate_logits, pe_k, wk1, wk2, pe_v, wv1, wv2):
    B, T, _ = q.shape
    G, Hg, dh = NSA_KV_GROUPS, HEADS_PER_GROUP, HEAD_DIM
    n_qb = T // Q_BLOCK
    n_cmp = (T - CMP_BLOCK) // CMP_STRIDE + 1
    n_blk = T // SEL_BLOCK
    n_sel = min(N_SEL, n_blk)

    q = q.reshape(B, T, G, Hg, dh).transpose(0, 2, 3, 1, 4) * (dh ** -0.5)
    to_kv = lambda a: a.reshape(B, T, G, dh).transpose(0, 2, 1, 3)
    kc = compress(to_kv(k_c), pe_k, wk1, wk2)
    vc = compress(to_kv(v_c), pe_v, wv1, wv2)
    ks = to_kv(k_s).reshape(B, G, n_blk, SEL_BLOCK, dh)
    vs = to_kv(v_s).reshape(B, G, n_blk, SEL_BLOCK, dh)
    pad = ((0, 0), (0, 0), (WINDOW, 0), (0, 0))
    kw = jnp.pad(to_kv(k_w), pad)
    vw = jnp.pad(to_kv(v_w), pad)
    gates = jax.nn.sigmoid(gate_logits.astype(jnp.float32)).reshape(B, T, G, Hg, 3).transpose(0, 2, 3, 1, 4)

    slopes = jnp.asarray(alibi_slopes(NSA_HEADS)).reshape(G, Hg, 1, 1)
    cmp_pos = jnp.arange(n_cmp) * CMP_STRIDE + (CMP_BLOCK - 1)
    ci = np.arange(n_cmp)[:, None] * CMP_STRIDE
    sj = np.arange(n_blk)[None, :] * SEL_BLOCK
    overlap = jnp.asarray(((ci <= sj + SEL_BLOCK - 1) & (ci + CMP_BLOCK - 1 >= sj)).astype(np.float32))
    blk_ids = jnp.arange(n_blk)
    b_i = jnp.arange(B)[:, None, None, None]
    g_i = jnp.arange(G)[None, :, None, None]

    def one_block(args):
        qb, gb, qi = args
        t = qi * Q_BLOCK + jnp.arange(Q_BLOCK)
        dist_c = t[:, None] - cmp_pos[None, :]
        s_c = jnp.einsum('bghqd,bgcd->bghqc', qb, kc) - slopes * dist_c
        p_c = masked_softmax(s_c, dist_c >= 0)
        o_cmp = jnp.einsum('bghqc,bgcd->bghqd', p_c, vc.astype(jnp.float32))
        imp = jnp.einsum('bghqc,cn->bgqn', p_c, overlap)
        cur = t // SEL_BLOCK
        valid = blk_ids[None, :] <= cur[:, None]
        forced = ((blk_ids[None, :] == 0) | (blk_ids[None, :] == cur[:, None]) |
                  (blk_ids[None, :] == cur[:, None] - 1)) & valid
        imp = jnp.where(forced, jnp.inf, jnp.where(valid, imp, -jnp.inf))
        _, idx = lax.top_k(imp, n_sel)
        k_sel = ks[b_i, g_i, idx]
        v_sel = vs[b_i, g_i, idx]
        pos = idx[..., None] * SEL_BLOCK + jnp.arange(SEL_BLOCK)
        dist_s = t[None, None, :, None, None] - pos
        s_s = jnp.einsum('bghqd,bgqnld->bghqnl', qb, k_sel) - slopes[..., None] * dist_s[:, :, None]
        n_keys = n_sel * SEL_BLOCK
        p_s = masked_softmax(s_s.reshape(B, G, Hg, Q_BLOCK, n_keys),
                             (dist_s >= 0).reshape(B, G, 1, Q_BLOCK, n_keys))
        o_slc = jnp.einsum('bghqk,bgqkd->bghqd', p_s,
                           v_sel.reshape(B, G, Q_BLOCK, n_keys, dh).astype(jnp.float32))
        kwb = lax.dynamic_slice_in_dim(kw, qi * Q_BLOCK, WINDOW + Q_BLOCK, axis=2)
        vwb = lax.dynamic_slice_in_dim(vw, qi * Q_BLOCK, WINDOW + Q_BLOCK, axis=2)
        key_pos = qi * Q_BLOCK - WINDOW + jnp.arange(WINDOW + Q_BLOCK)
        dist_w = t[:, None] - key_pos[None, :]
        mask_w = (dist_w >= 0) & (dist_w < WINDOW) & (key_pos[None, :] >= 0)
        s_w = jnp.einsum('bghqd,bgkd->bghqk', qb, kwb) - slopes * dist_w
        p_w = masked_softmax(s_w, mask_w)
        o_win = jnp.einsum('bghqk,bgkd->bghqd', p_w, vwb.astype(jnp.float32))
        return gb[..., 0:1] * o_cmp + gb[..., 1:2] * o_slc + gb[..., 2:3] * o_win

    qs = q.reshape(B, G, Hg, n_qb, Q_BLOCK, dh).transpose(3, 0, 1, 2, 4, 5)
    gs = gates.reshape(B, G, Hg, n_qb, Q_BLOCK, 3).transpose(3, 0, 1, 2, 4, 5)
    out = lax.map(one_block, (qs, gs, jnp.arange(n_qb)))
    out = out.transpose(1, 0, 4, 2, 3, 5).reshape(B, T, NSA_HEADS * dh)
    return out.astype(q.dtype)


def pool_mixer(u, w_pool, scale):
    B, T, _ = u.shape
    uf = u.astype(jnp.float32)
    c = jnp.pad(jnp.cumsum(uf, axis=1), ((0, 0), (1, 0), (0, 0)))
    t = jnp.arange(T)
    outs = []
    for gi, w in enumerate(POOL_WIDTHS):
        sl = slice(gi * POOL_GROUP, (gi + 1) * POOL_GROUP)
        lo = jnp.maximum(t + 1 - w, 0)
        cnt = jnp.minimum(t + 1, w).astype(jnp.float32)[:, None]
        outs.append((c[:, t + 1, sl] - c[:, lo, sl]) / cnt - uf[..., sl])
    y = jnp.stack(outs, axis=2)
    y = jnp.einsum('btgc,gcd->btgd', y, w_pool.astype(jnp.float32)).reshape(B, T, POOL_CH)
    return (y * scale.astype(jnp.float32)).astype(u.dtype)


def setup_inputs(seed: int = 0) -> dict:
    key = jax.random.key(seed)
    ks = jax.random.split(key, 24)
    n = lambda k, shape, s: jax.random.normal(k, shape, jnp.float32) * s
    gain = lambda k, shape: 1.0 + 0.02 * jax.random.normal(k, shape, jnp.float32)
    L = DEPTH
    return {
        "x": jax.random.normal(ks[0], (BATCH, SEQ, D_MODEL), jnp.float32),
        "ffn1_norm": gain(ks[1], (L, D_MODEL)),
        "ffn1_wg": n(ks[2], (L, D_MODEL, D_FF), D_MODEL ** -0.5),
        "ffn1_wu": n(ks[3], (L, D_MODEL, D_FF), D_MODEL ** -0.5),
        "ffn1_wd": n(ks[4], (L, D_FF, D_MODEL), D_FF ** -0.5),
        "mix_norm": gain(ks[5], (L, D_MODEL)),
        "w_in": n(ks[6], (L, D_MODEL, IN_WIDTH), D_MODEL ** -0.5),
        "cmp_pe_k": n(ks[7], (L, CMP_BLOCK, HEAD_DIM), 0.02),
        "cmp_wk1": n(ks[8], (L, CMP_BLOCK * HEAD_DIM, CMP_HIDDEN), (CMP_BLOCK * HEAD_DIM) ** -0.5),
        "cmp_wk2": n(ks[9], (L, CMP_HIDDEN, HEAD_DIM), CMP_HIDDEN ** -0.5),
        "cmp_pe_v": n(ks[10], (L, CMP_BLOCK, HEAD_DIM), 0.02),
        "cmp_wv1": n(ks[11], (L, CMP_BLOCK * HEAD_DIM, CMP_HIDDEN), (CMP_BLOCK * HEAD_DIM) ** -0.5),
        "cmp_wv2": n(ks[12], (L, CMP_HIDDEN, HEAD_DIM), CMP_HIDDEN ** -0.5),
        "pool_w": n(ks[13], (L, len(POOL_WIDTHS), POOL_GROUP, POOL_GROUP), POOL_GROUP ** -0.5),
        "pool_scale": 1.0 + 0.1 * jax.random.normal(ks[14], (L, POOL_CH), jnp.float32),
        "w_out": n(ks[15], (L, MIX_WIDTH, D_MODEL), MIX_WIDTH ** -0.5),
        "ffn2_norm": gain(ks[16], (L, D_MODEL)),
        "ffn2_wg": n(ks[17], (L, D_MODEL, D_FF), D_MODEL ** -0.5),
        "ffn2_wu": n(ks[18], (L, D_MODEL, D_FF), D_MODEL ** -0.5),
        "ffn2_wd": n(ks[19], (L, D_FF, D_MODEL), D_FF ** -0.5),
        "final_norm": gain(ks[20], (D_MODEL,)),
    }


def reference(x, ffn1_norm, ffn1_wg, ffn1_wu, ffn1_wd, mix_norm, w_in, cmp_pe_k, cmp_wk1, cmp_wk2,
              cmp_pe_v, cmp_wv1, cmp_wv2, pool_w, pool_scale, w_out, ffn2_norm, ffn2_wg, ffn2_wu,
              ffn2_wd, final_norm):
    split_at = list(np.cumsum(IN_SPLITS)[:-1])
    for l in range(DEPTH):
        x = x + 0.5 * swiglu(rms_norm(x, ffn1_norm[l]), ffn1_wg[l], ffn1_wu[l], ffn1_wd[l])
        z = rms_norm(x, mix_norm[l]) @ w_in[l]
        q, k_c, v_c, k_s, v_s, k_w, v_w, g_logit, u = jnp.split(z, split_at, axis=-1)
        o_nsa = nsa_mixer(q, k_c, v_c, k_s, v_s, k_w, v_w, g_logit,
                          cmp_pe_k[l], cmp_wk1[l], cmp_wk2[l], cmp_pe_v[l], cmp_wv1[l], cmp_wv2[l])
        o_pool = pool_mixer(u, pool_w[l], pool_scale[l])
        x = x + jnp.concatenate([o_nsa, o_pool.astype(o_nsa.dtype)], axis=-1).astype(x.dtype) @ w_out[l]
        x = x + 0.5 * swiglu(rms_norm(x, ffn2_norm[l]), ffn2_wg[l], ffn2_wu[l], ffn2_wd[l])
    return rms_norm(x, final_norm)
```

```cpp
#include <hip/hip_runtime.h>
#include <hip/hip_cooperative_groups.h>
#include <cstdio>
#include <cstdint>
namespace cg = cooperative_groups;

#define LAS __attribute__((address_space(3)))
typedef unsigned short bf16_t;
typedef short bf16x8 __attribute__((ext_vector_type(8)));
typedef short s16x4 __attribute__((ext_vector_type(4)));
typedef float f32x2 __attribute__((ext_vector_type(2)));
typedef float f32x4 __attribute__((ext_vector_type(4)));
typedef float f32x16 __attribute__((ext_vector_type(16)));
typedef unsigned u32x2 __attribute__((ext_vector_type(2)));
typedef unsigned u32x4 __attribute__((ext_vector_type(4)));
typedef __bf16 bf16x2_t __attribute__((ext_vector_type(2)));

constexpr int BATCH = 8, T = 4096, D = 1024, FF = 2816, DEPTH = 4;
constexpr int M = BATCH * T;
constexpr int NZ = 2048;
constexpr int INW = 1816;
constexpr int ZQ = 0, ZKC = 512, ZVC = 640, ZKS = 768, ZVS = 896, ZKW = 1024, ZVW = 1152, ZG = 1280, ZU = 1304;
constexpr float EPS = 1e-6f;
constexpr float LOG2E = 1.4426950408889634f;
constexpr float C2 = 0.125f * LOG2E;
constexpr int NWAVES = 8;

constexpr size_t MiB = 1u << 20;
constexpr size_t LW_F1 = 0;
constexpr size_t LW_D1 = LW_F1 + (size_t)2 * FF * D * 2;
constexpr size_t LW_F2 = LW_D1 + (size_t)D * FF * 2;
constexpr size_t LW_D2 = LW_F2 + (size_t)2 * FF * D * 2;
constexpr size_t LW_IN = LW_D2 + (size_t)D * FF * 2;
constexpr size_t LW_OUT = LW_IN + (size_t)NZ * D * 2;
constexpr size_t LW_CK1 = LW_OUT + (size_t)D * D * 2;
constexpr size_t LW_CV1 = LW_CK1 + (size_t)128 * 2048 * 2;
constexpr size_t LW_CK2 = LW_CV1 + (size_t)128 * 2048 * 2;
constexpr size_t LW_CV2 = LW_CK2 + (size_t)64 * 128 * 2;
constexpr size_t LW_CBK = LW_CV2 + (size_t)64 * 128 * 2;
constexpr size_t LW_CBV = LW_CBK + 512;
constexpr size_t LW_END = LW_CBV + 512;
constexpr size_t LW_STRIDE = 41 * MiB;
static_assert(LW_END <= LW_STRIDE, "layer weight block");
constexpr size_t WS_W = 0;
constexpr size_t WS_SSQ = WS_W + DEPTH * LW_STRIDE;
constexpr size_t WS_KC = WS_SSQ + (size_t)16 * M * 4;
constexpr size_t WS_XB = WS_KC + 1 * MiB;
constexpr size_t WS_BIG = WS_XB + (size_t)M * D * 2;
constexpr size_t ARENA_B = 24 * MiB, ARENA_E = ARENA_B / 2;
constexpr size_t PAD_ACT = ARENA_E - (size_t)T * FF, PAD_Z = ARENA_E - (size_t)T * NZ, PAD_MIX = ARENA_E - (size_t)T * D;
constexpr size_t WS_Z = WS_BIG, WS_MIX = WS_BIG + 16 * MiB;
static_assert((size_t)T * FF * 2 <= ARENA_B && (size_t)T * NZ * 2 <= 16 * MiB && (size_t)T * D * 2 <= 8 * MiB && BATCH * ARENA_B <= 192 * MiB, "arenas");
constexpr size_t WS_CTL = WS_BIG + (size_t)192 * MiB;
constexpr size_t WS_END = WS_CTL + 1 * MiB;
constexpr size_t CTL_ZERO_BYTES = 32768;
static_assert((size_t)M * FF * 2 <= 192 * MiB && WS_END <= (size_t)512 * MiB, "d_ws map");

__device__ __forceinline__ float xadd16(float v) { const unsigned u = __builtin_bit_cast(unsigned, v); auto rr = __builtin_amdgcn_permlane16_swap(u, u, false, false); return __builtin_bit_cast(float, (unsigned)rr[0]) + __builtin_bit_cast(float, (unsigned)rr[1]); }
__device__ __forceinline__ float xadd32(float v) { const unsigned u = __builtin_bit_cast(unsigned, v); auto rr = __builtin_amdgcn_permlane32_swap(u, u, false, false); return __builtin_bit_cast(float, (unsigned)rr[0]) + __builtin_bit_cast(float, (unsigned)rr[1]); }
__device__ __forceinline__ float xmax32(float v) { const unsigned u = __builtin_bit_cast(unsigned, v); auto rr = __builtin_amdgcn_permlane32_swap(u, u, false, false); return fmaxf(__builtin_bit_cast(float, (unsigned)rr[0]), __builtin_bit_cast(float, (unsigned)rr[1])); }
namespace pg8 {
constexpr int BM = 256, BK = 64, HALF = 128, HTB = HALF * BK * 2, STAGE_BYTES = 8 * HTB, NXCD = 8, WGM = 8;
__host__ __device__ __forceinline__ int lds_byte(int r, int c) { const int st = (r >> 4) * 2 + (c >> 5), rr = r & 15, cc = c & 31, ob = rr * 64 + cc * 2; return st * 1024 + (ob ^ (((ob >> 9) & 1) << 5)); }
__host__ __device__ __forceinline__ void stage_rc(int b, int& R, int& C) { const int st = b / 1024, sb = b % 1024, swz = sb ^ (((sb >> 9) & 1) << 5); R = (st >> 1) * 16 + swz / 64; C = (st & 1) * 32 + (swz % 64) / 2; }
__host__ __device__ __forceinline__ int perm32(int rho) { const int n = rho >> 4, i = rho & 15; return 8 * (i >> 2) + 4 * n + (i & 3); }
struct Unit { int pm, pn; };
struct Gemm { const bf16_t* A; const bf16_t* Bt; int M, N, K; size_t padA; };
struct StaticOrder {
    int nM, nN, nwg, G, c;
    __host__ __device__ void init(int M_, int N_, int G_, int c_) { nM = M_ / BM; nN = N_ / BM; nwg = nM * nN; G = G_; c = c_; }
    __host__ __device__ bool next(int i, Unit& u) const {
        const long L = (long)i * G + c; if (L >= nwg) return false;
        int wgid = (int)L; { const int q = nwg / NXCD, r = nwg % NXCD, xcd = wgid % NXCD, off = wgid / NXCD; wgid = (xcd < r ? xcd * (q + 1) : r * (q + 1) + (xcd - r) * q) + off; }
        const int nig = WGM * nN, gid = wgid / nig, fm = gid * WGM, gsz = (nM - fm) < WGM ? (nM - fm) : WGM;
        u.pm = fm + ((wgid % nig) % gsz); u.pn = (wgid % nig) / gsz; return true;
    }
};
__device__ __forceinline__ unsigned cvt_pk_bf16(float lo, float hi) { unsigned r; asm volatile("v_cvt_pk_bf16_f32 %0, %1, %2" : "=v"(r) : "v"(lo), "v"(hi)); return r; }

constexpr int RS_OFF = 131072;
__device__ __forceinline__ float row_rstd(const LAS unsigned char* lds, int row_local, int fq) {
    const f32x4 pv = *(const LAS f32x4*)(lds + RS_OFF + row_local * 64 + fq * 16);
    float s = (pv[0] + pv[1]) + (pv[2] + pv[3]);
    s = xadd16(s); s = xadd32(s);
    return __builtin_amdgcn_rsqf(s * (1.0f / D) + EPS);
}
struct EpiSwiGLU {
    static constexpr bool PERM = true, RSTD = true;
    bf16_t* O; const float* ssq;
    __device__ __forceinline__ void operator()(const f32x4 (&acc)[2][2][4][2], const Unit& u, int wr, int wc, int fr, int fq, const LAS unsigned char* lds) const {
        const int row0 = u.pm * BM + wr * 64 + fr, col0 = u.pn * HALF + wc * 32 + 8 * fq;
        float rsv[2][4];
#pragma unroll
        for (int ai = 0; ai < 2; ++ai)
#pragma unroll
            for (int m = 0; m < 4; ++m) rsv[ai][m] = row_rstd(lds, wr * 64 + fr + ai * HALF + m * 16, fq);
        asm volatile("s_waitcnt lgkmcnt(0)\n\ts_barrier" ::: "memory");
#pragma unroll
        for (int ai = 0; ai < 2; ++ai)
#pragma unroll
            for (int m = 0; m < 4; ++m) {
                const int row = row0 + ai * HALF + m * 16; const float rs = rsv[ai][m];
                float a[8];
                const float c1 = -rs * LOG2E, rs2 = rs * rs;
#pragma unroll
                for (int n = 0; n < 2; ++n)
#pragma unroll
                    for (int j = 0; j < 4; ++j) { const float ag = acc[ai][0][m][n][j], au = acc[ai][1][m][n][j];
                        a[n * 4 + j] = (ag * au) * (rs2 * __builtin_amdgcn_rcpf(1.0f + __builtin_amdgcn_exp2f(ag * c1))); }
                u32x4 w; w.x = cvt_pk_bf16(a[0], a[1]); w.y = cvt_pk_bf16(a[2], a[3]); w.z = cvt_pk_bf16(a[4], a[5]); w.w = cvt_pk_bf16(a[6], a[7]);
                *(u32x4*)(O + (size_t)row * FF + (size_t)(row >> 12) * PAD_ACT + col0) = w;
            }
    }
};
struct EpiZ {
    static constexpr bool PERM = true, RSTD = true;
    bf16_t* O; const float* ssq;
    __device__ __forceinline__ void operator()(const f32x4 (&acc)[2][2][4][2], const Unit& u, int wr, int wc, int fr, int fq, const LAS unsigned char* lds) const {
        const int row0 = u.pm * BM + wr * 64 + fr, colt = u.pn * BM, col0 = colt + wc * 32 + 8 * fq;
        const float sc = (colt < 512) ? C2 : 1.0f;
        float rsv[2][4];
#pragma unroll
        for (int ai = 0; ai < 2; ++ai)
#pragma unroll
            for (int m = 0; m < 4; ++m) rsv[ai][m] = row_rstd(lds, wr * 64 + fr + ai * HALF + m * 16, fq) * sc;
        asm volatile("s_waitcnt lgkmcnt(0)\n\ts_barrier" ::: "memory");
#pragma unroll
        for (int ai = 0; ai < 2; ++ai)
#pragma unroll
            for (int m = 0; m < 4; ++m) {
                const int row = row0 + ai * HALF + m * 16; const float rs = rsv[ai][m];
#pragma unroll
                for (int bj = 0; bj < 2; ++bj) { const f32x4 v0 = acc[ai][bj][m][0] * rs, v1 = acc[ai][bj][m][1] * rs;
                    u32x4 w; w.x = cvt_pk_bf16(v0[0], v0[1]); w.y = cvt_pk_bf16(v0[2], v0[3]); w.z = cvt_pk_bf16(v1[0], v1[1]); w.w = cvt_pk_bf16(v1[2], v1[3]);
                    *(u32x4*)(O + (size_t)row * NZ + (size_t)(row >> 12) * PAD_Z + col0 + bj * HALF) = w; }
            }
    }
};
struct EpiResid {
    static constexpr bool PERM = true, RSTD = false;
    bf16_t* xb; float* ssq; float alpha;
    __device__ __forceinline__ void operator()(const f32x4 (&acc)[2][2][4][2], const Unit& u, int wr, int wc, int fr, int fq, const LAS unsigned char*) const {
        const int row0 = u.pm * BM + wr * 64 + fr, col0 = u.pn * BM + wc * 32 + 8 * fq;
#pragma unroll
        for (int ai = 0; ai < 2; ++ai) {
            u32x4 pre[4][2];
#pragma unroll
            for (int m = 0; m < 4; ++m)
#pragma unroll
                for (int bj = 0; bj < 2; ++bj) pre[m][bj] = *(const u32x4*)(xb + (size_t)(row0 + ai * HALF + m * 16) * D + col0 + bj * HALF);
#pragma unroll
            for (int m = 0; m < 4; ++m) {
                const int row = row0 + ai * HALF + m * 16; const size_t off = (size_t)row * D + col0; float ss = 0.f;
#pragma unroll
                for (int bj = 0; bj < 2; ++bj) { const u32x4 pv = pre[m][bj];
                    const f32x4 x0 = {__builtin_bit_cast(float, pv.x << 16), __builtin_bit_cast(float, pv.x & 0xffff0000u), __builtin_bit_cast(float, pv.y << 16), __builtin_bit_cast(float, pv.y & 0xffff0000u)};
                    const f32x4 x1 = {__builtin_bit_cast(float, pv.z << 16), __builtin_bit_cast(float, pv.z & 0xffff0000u), __builtin_bit_cast(float, pv.w << 16), __builtin_bit_cast(float, pv.w & 0xffff0000u)};
                    const f32x4 o0 = x0 + acc[ai][bj][m][0] * alpha, o1 = x1 + acc[ai][bj][m][1] * alpha;
                    ss += ((o0[0] * o0[0] + o0[1] * o0[1]) + (o0[2] * o0[2] + o0[3] * o0[3])) + ((o1[0] * o1[0] + o1[1] * o1[1]) + (o1[2] * o1[2] + o1[3] * o1[3]));
                    u32x4 w; w.x = cvt_pk_bf16(o0[0], o0[1]); w.y = cvt_pk_bf16(o0[2], o0[3]); w.z = cvt_pk_bf16(o1[0], o1[1]); w.w = cvt_pk_bf16(o1[2], o1[3]);
                    *(u32x4*)(xb + off + bj * HALF) = w; }
                ss = xadd16(ss); ss = xadd32(ss);
                if (fq == 0) ssq[(size_t)row * 16 + u.pn * 4 + wc] = ss;
            }
            asm volatile("" ::: "memory");
        }
    }
};

template <class Epi, bool ALIGN_EPI = true>
__device__ __forceinline__ void gemm_phase(LAS unsigned char* lds, const Gemm g, const StaticOrder& S, const Epi& E) {
    int tid = threadIdx.x; asm volatile("" : "+v"(tid));
    const int wid = __builtin_amdgcn_readfirstlane(tid >> 6), lane = tid & 63, wr = wid >> 2, wc = wid & 3, fr = lane & 15, fq = lane >> 4;
    const int K = g.K, nt = K / BK;
    unsigned voffA[2], voffB[2];
#pragma unroll
    for (int i = 0; i < 2; ++i) { int R, C; stage_rc(tid * 16 + i * 8192, R, C); const int Rb = Epi::PERM ? ((R & ~31) + perm32(R & 31)) : R;
        voffA[i] = (unsigned)(R * K + C) * 2u; voffB[i] = (unsigned)(Rb * K + C) * 2u; }
    const size_t kstep = (size_t)(BK * 2);
    const size_t hstep = (size_t)HALF * K * 2;
    const size_t tstep = 2 * hstep;
    const unsigned ldsw = (unsigned)wid * 1024u;
    const int aoff = lds_byte(wr * 64 + fr, fq * 8), boff = lds_byte(wc * 32 + fr, fq * 8);
#define PG8_SA(b, h) (((b) * 2 + (h)) * HTB)
#define PG8_SB(b, h) ((4 + (b) * 2 + (h)) * HTB)
#define PG8_STAGE(bufoff, gbase, voff) do { _Pragma("unroll") for (int _i = 0; _i < 2; ++_i) \
        __builtin_amdgcn_global_load_lds((const unsigned*)((const char*)(gbase) + (voff)[_i]), (LAS unsigned*)(lds + (bufoff) + ldsw + _i * 8192), 16, 0, 0); } while (0)
#define PG8_LDA(dst, b, h) do { _Pragma("unroll") for (int m = 0; m < 4; ++m) _Pragma("unroll") for (int k = 0; k < 2; ++k) dst[m][k] = *(const LAS bf16x8*)(lds + PG8_SA(b, h) + aoff + m * 2048 + k * 1024); } while (0)
#define PG8_LDB(dst, b, h) do { _Pragma("unroll") for (int n = 0; n < 2; ++n) _Pragma("unroll") for (int k = 0; k < 2; ++k) dst[n][k] = *(const LAS bf16x8*)(lds + PG8_SB(b, h) + boff + n * 2048 + k * 1024); } while (0)
#define PG8_MMA(ai, bj, At, Bt) do { __builtin_amdgcn_s_setprio(1); _Pragma("unroll") for (int m = 0; m < 4; ++m) _Pragma("unroll") for (int n = 0; n < 2; ++n) _Pragma("unroll") for (int k = 0; k < 2; ++k) \
        acc[ai][bj][m][n] = __builtin_amdgcn_mfma_f32_16x16x32_bf16(Bt[n][k], At[m][k], acc[ai][bj][m][n], 0, 0, 0); __builtin_amdgcn_s_setprio(0); } while (0)
#define PG8_WAIT_V(n) asm volatile("s_waitcnt vmcnt(" #n ")" ::: "memory")
#define PG8_WAIT_L(n) asm volatile("s_waitcnt lgkmcnt(" #n ")" ::: "memory")
#define PG8_BAR __builtin_amdgcn_s_barrier()
#define PG8_SCHED __builtin_amdgcn_sched_barrier(0)
    Unit cur, nxt; int ui = 0;
    if (!S.next(0, cur)) return;
    f32x4 acc[2][2][4][2];
#pragma unroll
    for (int a = 0; a < 2; ++a)
#pragma unroll
        for (int b = 0; b < 2; ++b)
#pragma unroll
            for (int m = 0; m < 4; ++m)
#pragma unroll
                for (int n = 0; n < 2; ++n) acc[a][b][m][n] = (f32x4){0.f, 0.f, 0.f, 0.f};
    bf16x8 At[4][2], B0[2][2], B1[2][2];
    const char* cA = (const char*)g.A + (size_t)cur.pm * tstep + (size_t)(cur.pm >> 4) * g.padA; const char* cB = (const char*)g.Bt + (size_t)cur.pn * tstep;
    PG8_STAGE(PG8_SB(0, 0), cB, voffB); PG8_STAGE(PG8_SB(0, 1), cB + hstep, voffB); PG8_STAGE(PG8_SA(0, 0), cA, voffA); PG8_STAGE(PG8_SA(0, 1), cA + hstep, voffA);
    if (wr == 1) PG8_BAR;
    PG8_WAIT_V(2); PG8_BAR;
    PG8_STAGE(PG8_SB(1, 0), cB + kstep, voffB); PG8_STAGE(PG8_SA(1, 0), cA + kstep, voffA); PG8_STAGE(PG8_SB(1, 1), cB + hstep + kstep, voffB);
    PG8_WAIT_V(6); PG8_BAR;
#define PG8_RS_DMA(unit) do { if constexpr (Epi::RSTD) { \
        const unsigned loff_ = ldsw + (unsigned)((fq << 4) + fr) * 16u; \
        const char* rb0_ = (const char*)E.ssq + (size_t)(unit).pm * (BM * 64); const char* rb1_ = rb0_ + 8192; \
        const unsigned m0a_ = (unsigned)(__SIZE_TYPE__)(lds + RS_OFF) + ldsw, m0b_ = m0a_ + 8192u; unsigned keep_; \
        asm volatile("s_mov_b32 %0, m0\n\ts_mov_b32 m0, %2\n\ts_nop 0\n\tglobal_load_lds_dwordx4 %1, %3\n\ts_mov_b32 m0, %4\n\ts_nop 0\n\tglobal_load_lds_dwordx4 %1, %5\n\ts_mov_b32 m0, %0" \
                     : "=&s"(keep_) : "v"(loff_), "s"(m0a_), "s"(rb0_), "s"(m0b_), "s"(rb1_) : "memory"); } } while (0)
    PG8_RS_DMA(cur);
    for (;;) {
        const bool has_next = S.next(ui + 1, nxt);
        const char* nA = has_next ? (const char*)g.A + (size_t)nxt.pm * tstep + (size_t)(nxt.pm >> 4) * g.padA : cA; const char* nB = has_next ? (const char*)g.Bt + (size_t)nxt.pn * tstep : cB;
        for (int t = 0; t < nt; t += 2) {
            const bool last = (t == nt - 2);
            const char* a1 = cA + (size_t)(t + 1) * kstep;
            const char* a2 = last ? nA : cA + (size_t)(t + 2) * kstep; const char* b2 = last ? nB : cB + (size_t)(t + 2) * kstep;
            const char* a3 = a2 + kstep; const char* b3 = b2 + kstep;
            PG8_LDB(B0, 0, 0); PG8_LDB(B1, 0, 1); PG8_SCHED; PG8_LDA(At, 0, 0); PG8_STAGE(PG8_SA(1, 1), a1 + hstep, voffA);
            PG8_WAIT_V(8); PG8_WAIT_L(0); PG8_BAR;
            PG8_MMA(0, 0, At, B0); PG8_MMA(0, 1, At, B1); PG8_BAR; PG8_SCHED;
            PG8_LDA(At, 0, 1); PG8_STAGE(PG8_SB(0, 0), b2, voffB); PG8_STAGE(PG8_SB(0, 1), b2 + hstep, voffB); PG8_STAGE(PG8_SA(0, 0), a2, voffA);
            PG8_WAIT_V(8); PG8_WAIT_L(0); PG8_BAR; PG8_MMA(1, 0, At, B0); PG8_MMA(1, 1, At, B1); PG8_BAR; PG8_SCHED;
            PG8_LDB(B0, 1, 0); PG8_LDB(B1, 1, 1); PG8_SCHED; PG8_LDA(At, 1, 0); PG8_STAGE(PG8_SA(0, 1), a2 + hstep, voffA);
            PG8_WAIT_V(8); PG8_WAIT_L(0); PG8_BAR; PG8_MMA(0, 0, At, B0); PG8_MMA(0, 1, At, B1); PG8_BAR; PG8_SCHED;
            PG8_LDA(At, 1, 1); PG8_STAGE(PG8_SB(1, 0), b3, voffB); PG8_STAGE(PG8_SB(1, 1), b3 + hstep, voffB); PG8_STAGE(PG8_SA(1, 0), a3, voffA);
            PG8_WAIT_V(8); PG8_WAIT_L(0); PG8_BAR; PG8_MMA(1, 0, At, B0); PG8_MMA(1, 1, At, B1); PG8_BAR; PG8_SCHED;
        }
        if constexpr (ALIGN_EPI) { if (wr == 0) PG8_BAR; }
        E(acc, cur, wr, wc, fr, fq, lds);
        if (!has_next) break;
#pragma unroll
        for (int a = 0; a < 2; ++a)
#pragma unroll
            for (int b = 0; b < 2; ++b)
#pragma unroll
                for (int m = 0; m < 4; ++m)
#pragma unroll
                    for (int n = 0; n < 2; ++n) acc[a][b][m][n] = (f32x4){0.f, 0.f, 0.f, 0.f};
        cur = nxt; cA = nA; cB = nB; ++ui;
        PG8_RS_DMA(cur);
        if constexpr (ALIGN_EPI) { if (wr == 1) PG8_BAR; }
    }
    PG8_WAIT_V(0);
    if constexpr (!ALIGN_EPI) { if (wr == 0) PG8_BAR; }
    PG8_BAR;
#undef PG8_SA
#undef PG8_SB
#undef PG8_STAGE
#undef PG8_LDA
#undef PG8_LDB
#undef PG8_MMA
#undef PG8_WAIT_V
#undef PG8_WAIT_L
#undef PG8_BAR
#undef PG8_SCHED
#undef PG8_RS_DMA
}
}

__device__ __forceinline__ unsigned f2bf(float f) { unsigned u = __builtin_bit_cast(unsigned, f); return (u + 0x7fffu + ((u >> 16) & 1u)) >> 16; }
__device__ __forceinline__ unsigned pk2(float lo, float hi) { return f2bf(lo) | (f2bf(hi) << 16); }
__device__ __forceinline__ float bf2f(bf16_t v) { return __builtin_bit_cast(float, (unsigned)v << 16); }
__device__ __forceinline__ unsigned cvtpk(float lo, float hi) { f32x2 v = {lo, hi}; bf16x2_t b = __builtin_convertvector(v, bf16x2_t); return __builtin_bit_cast(unsigned, b); }
__device__ __forceinline__ float wave_sum(float v) {
#pragma unroll
    for (int o = 1; o < 64; o <<= 1) v += __shfl_xor(v, o);
    return v;
}
__device__ __forceinline__ float wave_max(float v) {
#pragma unroll
    for (int o = 1; o < 64; o <<= 1) v = fmaxf(v, __shfl_xor(v, o));
    return v;
}
#define LDS_FENCE() asm volatile("s_waitcnt lgkmcnt(0)" ::: "memory")
#define LBAR() asm volatile("s_waitcnt lgkmcnt(0)\n\ts_barrier" ::: "memory")

struct Args { const float* in[21]; float* out; unsigned char* ws; int ph_lo, ph_hi, dup, pad; };

__device__ __forceinline__ void tr_item(const float* W, int N, int Nvalid, int nblk, bf16_t* WT, int Kp, int MAP, const float* gain, LAS float* scr, int item, int lane) {
    const int kb = item / nblk, nb = item % nblk, k0 = 64 * kb, n0 = 64 * nb;
    const int nn = n0 + lane; const bool ok = nn < Nvalid;
    float tv[64];
#pragma unroll
    for (int i = 0; i < 64; ++i) tv[i] = ok ? W[(size_t)(k0 + i) * N + nn] : 0.f;
    if (gain) {
#pragma unroll
        for (int i = 0; i < 64; ++i) tv[i] *= gain[k0 + i];
    }
#pragma unroll
    for (int i = 0; i < 64; ++i) scr[i * 65 + lane] = tv[i];
    LDS_FENCE();
    const int c = lane & 7;
    int rbase = n0; if (MAP == 1 || MAP == 2) rbase = 256 * (n0 >> 7) + (n0 & 127) + (MAP == 2 ? 128 : 0);
#pragma unroll
    for (int j = 0; j < 8; ++j) { const int n = (lane >> 3) + 8 * j; const LAS float* sp = scr + (8 * c) * 65 + n;
        u32x4 o; o.x = pk2(sp[0 * 65], sp[1 * 65]); o.y = pk2(sp[2 * 65], sp[3 * 65]); o.z = pk2(sp[4 * 65], sp[5 * 65]); o.w = pk2(sp[6 * 65], sp[7 * 65]);
        if (MAP == 3) { const int nn2 = n0 + n, kk2 = k0 + 8 * c;
            *(u32x4*)(WT + ((size_t)(((nn2 >> 4) * 64 + (kk2 >> 5)) * 64 + ((kk2 >> 3) & 3) * 16 + (nn2 & 15))) * 8) = o; }
        else *(u32x4*)(WT + (size_t)(rbase + n) * Kp + k0 + 8 * c) = o; }
    LDS_FENCE();
}
constexpr int IT_FG = (D / 64) * (FF / 64);
constexpr int IT_FD = (FF / 64) * (D / 64);
constexpr int IT_IN = (D / 64) * (NZ / 64);
constexpr int IT_OUT = (512 / 64) * (D / 64);
constexpr int IT_C1 = (2048 / 64) * (128 / 64);
constexpr int IT_C2 = (128 / 64) * (64 / 64);
constexpr int IT_LAYER = 4 * IT_FG + 2 * IT_FD + IT_IN + IT_OUT + 2 * IT_C1 + 2 * IT_C2;

__device__ __forceinline__ void prologue(const Args& a, LAS unsigned char* lds, int G) {
    int tid = threadIdx.x; asm volatile("" : "+v"(tid));
    const int lane = tid & 63, wave = __builtin_amdgcn_readfirstlane(tid >> 6);
    LAS float* scr = (LAS float*)(lds + wave * 16640);
    const int gw = blockIdx.x * NWAVES + wave, NGW = G * NWAVES;
    unsigned char* ws = a.ws;
    for (int it = gw; it < DEPTH * IT_LAYER; it += NGW) {
        const int l = it / IT_LAYER; int r = it % IT_LAYER;
        unsigned char* lw = ws + WS_W + (size_t)l * LW_STRIDE;
        const size_t oF = (size_t)l * D * FF;
        if (r < IT_FG) { tr_item(a.in[2] + oF, FF, FF, FF / 64, (bf16_t*)(lw + LW_F1), D, 1, a.in[1] + l * D, scr, r, lane); continue; } r -= IT_FG;
        if (r < IT_FG) { tr_item(a.in[3] + oF, FF, FF, FF / 64, (bf16_t*)(lw + LW_F1), D, 2, a.in[1] + l * D, scr, r, lane); continue; } r -= IT_FG;
        if (r < IT_FG) { tr_item(a.in[17] + oF, FF, FF, FF / 64, (bf16_t*)(lw + LW_F2), D, 1, a.in[16] + l * D, scr, r, lane); continue; } r -= IT_FG;
        if (r < IT_FG) { tr_item(a.in[18] + oF, FF, FF, FF / 64, (bf16_t*)(lw + LW_F2), D, 2, a.in[16] + l * D, scr, r, lane); continue; } r -= IT_FG;
        if (r < IT_FD) { tr_item(a.in[4] + oF, D, D, D / 64, (bf16_t*)(lw + LW_D1), FF, 0, nullptr, scr, r, lane); continue; } r -= IT_FD;
        if (r < IT_FD) { tr_item(a.in[19] + oF, D, D, D / 64, (bf16_t*)(lw + LW_D2), FF, 0, nullptr, scr, r, lane); continue; } r -= IT_FD;
        if (r < IT_IN) { tr_item(a.in[6] + (size_t)l * D * INW, INW, INW, NZ / 64, (bf16_t*)(lw + LW_IN), D, 0, a.in[5] + l * D, scr, r, lane); continue; } r -= IT_IN;
        if (r < IT_OUT) { tr_item(a.in[15] + (size_t)l * D * D, D, D, D / 64, (bf16_t*)(lw + LW_OUT), D, 0, nullptr, scr, r, lane); continue; } r -= IT_OUT;
        if (r < IT_C1) { tr_item(a.in[8] + (size_t)l * 2048 * 128, 128, 128, 2, (bf16_t*)(lw + LW_CK1), 2048, 3, nullptr, scr, r, lane); continue; } r -= IT_C1;
        if (r < IT_C1) { tr_item(a.in[11] + (size_t)l * 2048 * 128, 128, 128, 2, (bf16_t*)(lw + LW_CV1), 2048, 3, nullptr, scr, r, lane); continue; } r -= IT_C1;
        if (r < IT_C2) { tr_item(a.in[9] + (size_t)l * 128 * 64, 64, 64, 1, (bf16_t*)(lw + LW_CK2), 128, 0, nullptr, scr, r, lane); continue; } r -= IT_C2;
        tr_item(a.in[12] + (size_t)l * 128 * 64, 64, 64, 1, (bf16_t*)(lw + LW_CV2), 128, 0, nullptr, scr, r, lane);
    }
    const int gt = blockIdx.x * (NWAVES * 64) + tid, NGT = G * NWAVES * 64;
    for (int i = gt; i < DEPTH * 512 * (D / 4); i += NGT) {
        const int n4 = i & (D / 4 - 1), gc = (i >> 8) & 511, l = i >> 17, g = gc >> 7;
        const float* pw = a.in[13] + ((size_t)l * 512 + gc) * 128; const float* sc = a.in[14] + l * 512 + g * 128;
        const float* wo = a.in[15] + ((size_t)l * D + 512 + g * 128) * D + 4 * n4;
        f32x4 s4 = {0.f, 0.f, 0.f, 0.f};
#pragma unroll 32
        for (int d = 0; d < 128; ++d) { const f32x4 w4 = *(const f32x4*)(wo + (size_t)d * D); s4 += w4 * (pw[d] * sc[d]); }
        bf16_t* o = (bf16_t*)(ws + WS_W + (size_t)l * LW_STRIDE + LW_OUT) + 512 + gc;
#pragma unroll
        for (int j = 0; j < 4; ++j) o[(size_t)(4 * n4 + j) * D] = (bf16_t)f2bf(s4[j]);
    }
    for (int i = gw; i < DEPTH * 2 * 128; i += NGW) {
        const int j = i & 127, kv = (i >> 7) & 1, l = i >> 8;
        const float* pe = a.in[kv ? 10 : 7] + (size_t)l * 2048; const float* w1 = a.in[kv ? 11 : 8] + (size_t)l * 2048 * 128 + j;
        float s = 0.f;
#pragma unroll
        for (int k = 0; k < 32; ++k) s += pe[lane + 64 * k] * w1[(size_t)(lane + 64 * k) * 128];
        s = wave_sum(s);
        if (lane == 0) ((float*)(ws + WS_W + (size_t)l * LW_STRIDE + (kv ? LW_CBV : LW_CBK)))[j] = s;
    }
    const float* x = a.in[0]; bf16_t* xb = (bf16_t*)(ws + WS_XB); float* ssq = (float*)(ws + WS_SSQ);
    for (int m0 = gw * 4; m0 < M; m0 += NGW * 4) {
        f32x4 v[4][4]; float sq[4];
#pragma unroll
        for (int rr = 0; rr < 4; ++rr)
#pragma unroll
            for (int j = 0; j < 4; ++j) v[rr][j] = ((const f32x4*)(x + (size_t)(m0 + rr) * D) + lane)[64 * j];
#pragma unroll
        for (int rr = 0; rr < 4; ++rr) { float s = 0.f; unsigned long long* o8 = (unsigned long long*)(xb + (size_t)(m0 + rr) * D) + lane;
#pragma unroll
            for (int j = 0; j < 4; ++j) { const f32x4 w = v[rr][j]; s += (w.x * w.x + w.y * w.y) + (w.z * w.z + w.w * w.w);
                o8[64 * j] = (unsigned long long)pk2(w.x, w.y) | ((unsigned long long)pk2(w.z, w.w) << 32); }
            sq[rr] = s; }
#pragma unroll
        for (int o = 1; o < 64; o <<= 1) {
#pragma unroll
            for (int rr = 0; rr < 4; ++rr) sq[rr] += __shfl_xor(sq[rr], o); }
#pragma unroll
        for (int rr = 0; rr < 4; ++rr) if (lane < 16) ssq[(size_t)(m0 + rr) * 16 + lane] = (lane == 0) ? sq[rr] : 0.f;
    }
}

__device__ __forceinline__ void compress_phase(LAS unsigned char* lds, const bf16_t* z, const unsigned char* lw, bf16_t* kcb, int part) {
    int tid = threadIdx.x; asm volatile("" : "+v"(tid));
    const int lane = tid & 63, wid = __builtin_amdgcn_readfirstlane(tid >> 6), r = lane & 15, q4 = lane >> 4;
    LAS unsigned char* slab = lds;
    LAS bf16_t* hid = (LAS bf16_t*)(lds + 528 * 128);
    const int u0 = part >= 0 ? (((part >> 3) >> 4) << 7) | ((((part & 7) << 1) | (((part >> 3) >> 3) & 1)) << 3) | ((part >> 3) & 7) : (int)blockIdx.x;
    for (int unit = u0; unit < 256; unit += (part >= 0 ? 256 : (int)gridDim.x)) {
        const int kv = unit >> 7, bg = (unit >> 3) & 15, ct = unit & 7, b = bg >> 1, g = bg & 1;
        const bf16_t* W1f = (const bf16_t*)(lw + (kv ? LW_CV1 : LW_CK1));
        const bf16_t* W2t = (const bf16_t*)(lw + (kv ? LW_CV2 : LW_CK2));
        const float* cb = (const float*)(lw + (kv ? LW_CBV : LW_CBK));
        const bf16_t* src = z + (size_t)b * ARENA_E + (kv ? ZVC : ZKC) + g * 64;
        u32x4 sv[9];
#pragma unroll
        for (int p = 0; p < 9; ++p) { const int idx = p * 512 + tid; int tl = idx >> 3; tl = tl < 528 ? tl : 527; const int ch = idx & 7;
            int tok = 512 * ct + tl; tok = tok < T ? tok : T - 1;
            sv[p] = *(const u32x4*)(src + (size_t)tok * NZ + ch * 8); }
#pragma unroll
        for (int p = 0; p < 9; ++p) { const int idx = p * 512 + tid, tl = idx >> 3, ch = idx & 7;
            if (tl < 528) *(LAS u32x4*)(slab + tl * 128 + ((ch ^ ((tl >> 4) & 7)) * 16)) = sv[p]; }
        __syncthreads();
        f32x4 acc0 = {0.f, 0.f, 0.f, 0.f}, acc1 = {0.f, 0.f, 0.f, 0.f};
        const bf16_t* bp = W1f + ((size_t)wid * 64 * 64 + lane) * 8;
#pragma unroll 16
        for (int s = 0; s < 64; ++s) {
            const bf16x8 bv = *(const bf16x8*)(bp + (size_t)s * 512);
            const int tl0 = 16 * r + (s >> 1), chx = (((s & 1) * 4 + q4) ^ ((r + (s >> 5)) & 7)) * 16;
            const bf16x8 a0 = *(const LAS bf16x8*)(slab + tl0 * 128 + chx);
            const bf16x8 a1 = *(const LAS bf16x8*)(slab + (tl0 + 256) * 128 + chx);
            acc0 = __builtin_amdgcn_mfma_f32_16x16x32_bf16(a0, bv, acc0, 0, 0, 0);
            acc1 = __builtin_amdgcn_mfma_f32_16x16x32_bf16(a1, bv, acc1, 0, 0, 0);
        }
        const float bias = cb[16 * wid + r];
        bf16x8 w2f[4];
#pragma unroll
        for (int s2 = 0; s2 < 4; ++s2) w2f[s2] = *(const bf16x8*)(W2t + (size_t)(16 * (wid & 3) + r) * 128 + s2 * 32 + q4 * 8);
#pragma unroll
        for (int rt = 0; rt < 2; ++rt)
#pragma unroll
            for (int j = 0; j < 4; ++j) { const float xh = (rt ? acc1[j] : acc0[j]) + bias; const float y2 = 2.0f * 0.7978845608028654f * (xh + 0.044715f * xh * xh * xh);
                const float ge = xh * __builtin_amdgcn_rcpf(1.0f + __builtin_amdgcn_exp2f(-y2 * LOG2E));
                hid[(16 * rt + 4 * q4 + j) * 136 + 16 * wid + r] = (bf16_t)f2bf(ge); }
        __syncthreads();
        {
            const int rt = wid >> 2, nt = wid & 3;
            f32x4 a2 = {0.f, 0.f, 0.f, 0.f};
#pragma unroll
            for (int s = 0; s < 4; ++s) {
                const bf16x8 av = *(const LAS bf16x8*)(hid + (16 * rt + r) * 136 + s * 32 + q4 * 8);
                a2 = __builtin_amdgcn_mfma_f32_16x16x32_bf16(av, w2f[s], a2, 0, 0, 0);
            }
#pragma unroll
            for (int j = 0; j < 4; ++j) { const int cc = ct * 32 + 16 * rt + 4 * q4 + j; const float v = cc <= 254 ? a2[j] : 0.f;
                kcb[((size_t)(kv * 16 + bg) * 256 + cc) * 64 + 16 * nt + r] = (bf16_t)f2bf(v); }
        }
        __syncthreads();
    }
}

template <int W> __device__ __forceinline__ void pool_chunk(const bf16_t* up, bf16_t* op, int t0) {
    float u0[16 + W - 1], u1[16 + W - 1];
#pragma unroll
    for (int i = 0; i < 16 + W - 1; ++i) { const int t = t0 - (W - 1) + i; unsigned v = 0u; if (t >= 0) v = *(const unsigned*)(up + (size_t)t * NZ);
        u0[i] = bf2f((bf16_t)(v & 0xffff)); u1[i] = bf2f((bf16_t)(v >> 16)); }
    float s0 = 0.f, s1 = 0.f;
#pragma unroll
    for (int i = 0; i < W - 1; ++i) { s0 += u0[i]; s1 += u1[i]; }
#pragma unroll
    for (int j = 0; j < 16; ++j) { const int t = t0 + j; s0 += u0[W - 1 + j]; s1 += u1[W - 1 + j];
        const int cnt = (t + 1) < W ? (t + 1) : W; const float ic = 1.0f / (float)cnt;
        *(unsigned*)(op + (size_t)t * D) = pk2(s0 * ic - u0[W - 1 + j], s1 * ic - u1[W - 1 + j]);
        s0 -= u0[j]; s1 -= u1[j]; }
}
constexpr int POOL_TASKS = BATCH * (T / 16) * 256, POOL_ITEM_TASKS = 1 * NWAVES * 64, NPOOL = POOL_TASKS / POOL_ITEM_TASKS;
__device__ __forceinline__ void pool_item(const bf16_t* z, bf16_t* mixin, int item) {
    int tid = threadIdx.x; asm volatile("" : "+v"(tid));
    for (int task = item * POOL_ITEM_TASKS + tid; task < (item + 1) * POOL_ITEM_TASKS; task += NWAVES * 64) {
        const int cp = task & 255, chunk = task >> 8, b = chunk >> 8, t0 = (chunk & 255) * 16, gi = cp >> 6;
        const bf16_t* up = z + (size_t)b * ARENA_E + ZU + 2 * cp;
        bf16_t* op = mixin + (size_t)b * ARENA_E + 512 + 2 * cp;
        if (gi == 0) pool_chunk<2>(up, op, t0); else if (gi == 1) pool_chunk<4>(up, op, t0); else if (gi == 2) pool_chunk<8>(up, op, t0); else pool_chunk<16>(up, op, t0);
    }
}

namespace att {
__device__ __forceinline__ int crow(int r, int hi) { return (r & 3) + 8 * (r >> 2) + 4 * hi; }
__device__ __forceinline__ void qkt(f32x16& p0, f32x16& p1, const LAS unsigned char* Kslot, const bf16x8* qr, int r32, int hi, float base, float sstride) {
    const LAS unsigned char* kb = Kslot + hi * 1024 + r32 * 16;
    const float b0v = base + (float)(4 * hi) * sstride, b1v = b0v + 32.0f * sstride;
#pragma unroll
    for (int r = 0; r < 16; ++r) { const float c = (float)((r & 3) + 8 * (r >> 2)); p0[r] = __builtin_fmaf(c, sstride, b0v); p1[r] = __builtin_fmaf(c, sstride, b1v); }
    bf16x8 kf0[4], kf1[4];
#pragma unroll
    for (int d0 = 0; d0 < 4; ++d0) { kf0[d0] = *(const LAS bf16x8*)(kb + d0 * 2048); kf1[d0] = *(const LAS bf16x8*)(kb + d0 * 2048 + 512); }
    __builtin_amdgcn_s_setprio(1);
#pragma unroll
    for (int d0 = 0; d0 < 4; ++d0) {
        p0 = __builtin_amdgcn_mfma_f32_32x32x16_bf16(kf0[d0], qr[d0], p0, 0, 0, 0);
        p1 = __builtin_amdgcn_mfma_f32_32x32x16_bf16(kf1[d0], qr[d0], p1, 0, 0, 0);
    }
    __builtin_amdgcn_s_setprio(0);
}
__device__ __forceinline__ s16x4 vtr(const LAS unsigned char* p) { return __builtin_bit_cast(s16x4, __builtin_amdgcn_ds_read_tr16_b64_v4i16((LAS s16x4*)p)); }
template <bool LE> __device__ __forceinline__ void mask_kv(f32x16& p0, f32x16& p1, int lim, int hi) {
    const int l0 = lim - 4 * hi, l1 = l0 - 32;
#pragma unroll
    for (int r = 0; r < 16; ++r) { const int c = (r & 3) + 8 * (r >> 2);
        const bool k0 = LE ? (c <= l0) : (c > l0), k1 = LE ? (c <= l1) : (c > l1);
        p0[r] = k0 ? p0[r] : -INFINITY; p1[r] = k1 ? p1[r] : -INFINITY; }
}
struct Sm { float mref, l, started; f32x16 o0, o1; };
__device__ __forceinline__ void sm_init(Sm& s) { s.mref = 0.f; s.l = 0.f; s.started = 0.f;
#pragma unroll
    for (int r = 0; r < 16; ++r) { s.o0[r] = 0.f; s.o1[r] = 0.f; } }
__device__ __forceinline__ void tile_update(Sm& st, f32x16& p0, f32x16& p1, const LAS unsigned char* Vslot, LAS float* wsf, int lane, int r32, int hi) {
    float mx = fmaxf(p0[0], p1[0]);
#pragma unroll
    for (int r = 1; r < 16; ++r) mx = fmaxf(mx, fmaxf(p0[r], p1[r]));
    mx = xmax32(mx);
    const bool need = (mx > 8.0f) || (st.started == 0.f && mx > -INFINITY);
    if (__any(need)) {
        const float dl = need ? mx : 0.f;
        const float f = (st.started != 0.f) ? __builtin_amdgcn_exp2f(-dl) : 1.0f;
        st.mref += dl; st.started = need ? 1.0f : st.started;
        st.l *= f;
#pragma unroll
        for (int r = 0; r < 16; ++r) { p0[r] -= dl; p1[r] -= dl; }
        if (hi == 0) wsf[r32] = f;
        LDS_FENCE();
#pragma unroll
        for (int i = 0; i < 4; ++i) { const f32x4 fv = *(const LAS f32x4*)(wsf + 4 * hi + 8 * i);
#pragma unroll
            for (int j = 0; j < 4; ++j) { st.o0[4 * i + j] *= fv[j]; st.o1[4 * i + j] *= fv[j]; } }
        LDS_FENCE();
    }
    float rs = 0.f;
#pragma unroll
    for (int r = 0; r < 16; ++r) { p0[r] = __builtin_amdgcn_exp2f(p0[r]); p1[r] = __builtin_amdgcn_exp2f(p1[r]); rs += p0[r] + p1[r]; }
    st.l += rs;
    u32x4 pw[4];
#pragma unroll
    for (int k = 0; k < 2; ++k) { pw[k] = (u32x4){cvtpk(p0[8 * k], p0[8 * k + 1]), cvtpk(p0[8 * k + 2], p0[8 * k + 3]), cvtpk(p0[8 * k + 4], p0[8 * k + 5]), cvtpk(p0[8 * k + 6], p0[8 * k + 7])};
        pw[2 + k] = (u32x4){cvtpk(p1[8 * k], p1[8 * k + 1]), cvtpk(p1[8 * k + 2], p1[8 * k + 3]), cvtpk(p1[8 * k + 4], p1[8 * k + 5]), cvtpk(p1[8 * k + 6], p1[8 * k + 7])}; }
    const LAS unsigned char* vp = Vslot + ((lane >> 4) & 1) * 32 + (lane & 3) * 8 + (4 * hi + ((lane & 15) >> 2)) * 64;
    __builtin_amdgcn_s_setprio(1);
#pragma unroll
    for (int ks = 0; ks < 4; ++ks) {
        const bf16x8 pa = __builtin_bit_cast(bf16x8, pw[ks]);
        { const s16x4 lo = vtr(vp + ks * 1024), hh = vtr(vp + ks * 1024 + 512);
          const bf16x8 vb = {lo[0], lo[1], lo[2], lo[3], hh[0], hh[1], hh[2], hh[3]};
          st.o0 = __builtin_amdgcn_mfma_f32_32x32x16_bf16(pa, vb, st.o0, 0, 0, 0); }
        { const s16x4 lo = vtr(vp + 4096 + ks * 1024), hh = vtr(vp + 4096 + ks * 1024 + 512);
          const bf16x8 vb = {lo[0], lo[1], lo[2], lo[3], hh[0], hh[1], hh[2], hh[3]};
          st.o1 = __builtin_amdgcn_mfma_f32_32x32x16_bf16(pa, vb, st.o1, 0, 0, 0); }
    }
    __builtin_amdgcn_s_setprio(0);
}
__device__ __forceinline__ void sm_finish(Sm& st, float gate, LAS float* wsf, int r32, int hi) {
    const float lt = xadd32(st.l);
    const float fac = lt > 0.f ? gate / lt : 0.f;
    if (hi == 0) wsf[r32] = fac;
    LDS_FENCE();
#pragma unroll
    for (int i = 0; i < 4; ++i) { const f32x4 fv = *(const LAS f32x4*)(wsf + 4 * hi + 8 * i);
#pragma unroll
        for (int j = 0; j < 4; ++j) { st.o0[4 * i + j] *= fv[j]; st.o1[4 * i + j] *= fv[j]; } }
    LDS_FENCE();
}
template <bool ADD> __device__ __forceinline__ void stage_acc(const Sm& st, LAS float* stgf, int r32, int hi) {
#pragma unroll
    for (int r = 0; r < 16; ++r) { const int q = crow(r, hi);
        if (ADD) { stgf[q * 64 + r32] += st.o0[r]; stgf[q * 64 + 32 + r32] += st.o1[r]; }
        else { stgf[q * 64 + r32] = st.o0[r]; stgf[q * 64 + 32 + r32] = st.o1[r]; } }
}
__device__ __forceinline__ float dpp_x1(float v) { return __builtin_bit_cast(float, __builtin_amdgcn_mov_dpp(__builtin_bit_cast(int, v), 0xB1, 0xF, 0xF, true)); }
__device__ __forceinline__ float dpp_x2(float v) { return __builtin_bit_cast(float, __builtin_amdgcn_mov_dpp(__builtin_bit_cast(int, v), 0x4E, 0xF, 0xF, true)); }
__device__ __forceinline__ float dpp_hm(float v) { return __builtin_bit_cast(float, __builtin_amdgcn_mov_dpp(__builtin_bit_cast(int, v), 0x141, 0xF, 0xF, true)); }
__device__ __forceinline__ int dpp_ix1(int v) { return __builtin_amdgcn_mov_dpp(v, 0xB1, 0xF, 0xF, true); }
__device__ __forceinline__ int dpp_ix2(int v) { return __builtin_amdgcn_mov_dpp(v, 0x4E, 0xF, 0xF, true); }
__device__ __forceinline__ int dpp_ihm(int v) { return __builtin_amdgcn_mov_dpp(v, 0x141, 0xF, 0xF, true); }
__device__ __forceinline__ float sigmoidf(float x) { return __builtin_amdgcn_rcpf(1.0f + __builtin_amdgcn_exp2f(-x * LOG2E)); }

constexpr int L_KC = 0, L_VC = 32768, L_KS = 65536, L_VS = 81920, L_WSF = 98304, L_IMP = 100352, L_SELM = 116736, L_WUN = 117248, L_TK = 117312, L_END = 117376;

__device__ __forceinline__ void attn_unit(LAS unsigned char* lds, const bf16_t* z, const bf16_t* __restrict__ kcb, bf16_t* mixin, int b, int g, int qblk, int skip, unsigned* qhead) {
    int tid = threadIdx.x; asm volatile("" : "+v"(tid));
    const int lane = tid & 63, r32 = lane & 31, hi = lane >> 5;
    const int wid = __builtin_amdgcn_readfirstlane(tid >> 6);
    const int bg = b * 2 + g, t0 = qblk * 64, cur = qblk;
    const int ql = wid * 8 + (r32 >> 2), h = r32 & 3, head = g * 4 + h, tq = t0 + ql;
    const size_t rowb = 0; z += (size_t)b * ARENA_E; mixin += (size_t)b * ARENA_E;
    LAS float* wsf = (LAS float*)(lds + L_WSF) + wid * 64;
    LAS float* impw = (LAS float*)(lds + L_IMP) + wid * 512;
    LAS unsigned long long* selm = (LAS unsigned long long*)(lds + L_SELM);
    LAS unsigned long long* wun = (LAS unsigned long long*)(lds + L_WUN);
    const int nc = (4 * qblk + 3) < 255 ? (4 * qblk + 3) : 255; const int nct = (nc + 63) >> 6;
    u32x4 kcr[4], vcr[4];
#pragma unroll
    for (int j = 0; j < 4; ++j) if (j < nct) {
        kcr[j] = *(const u32x4*)(kcb + ((size_t)bg * 256 + 64 * j + lane) * 64 + wid * 8);
        vcr[j] = *(const u32x4*)(kcb + ((size_t)(16 + bg) * 256 + 64 * j + 16 * (wid & 3) + (lane >> 2)) * 64 + (wid >> 2) * 32 + (lane & 3) * 8); }
    bf16x8 qr[4];
    { const bf16_t* qp = z + (rowb + tq) * NZ + ZQ + head * 64 + hi * 8;
#pragma unroll
      for (int d0 = 0; d0 < 4; ++d0) qr[d0] = *(const bf16x8*)(qp + d0 * 16); }
    const bf16_t* gp = z + (rowb + tq) * NZ + ZG + head * 3;
    const float g_cmp = sigmoidf(bf2f(gp[0])), g_slc = sigmoidf(bf2f(gp[1])), g_win = sigmoidf(bf2f(gp[2]));
    const float slope2 = __builtin_amdgcn_exp2f(-(float)(head + 1)) * LOG2E;
#define ISSUE(kr, vr, d) do { const int n_ = (d) & 255; const int kc_ = ((d) & 256) ? ZKS : ZKW, vc_ = ((d) & 256) ? ZVS : ZVW; \
        kr = *(const u32x4*)(z + (rowb + 64 * n_ + lane) * NZ + kc_ + g * 64 + wid * 8); \
        vr = *(const u32x4*)(z + (rowb + 64 * n_ + 16 * (wid & 3) + (lane >> 2)) * NZ + vc_ + g * 64 + (wid >> 2) * 32 + (lane & 3) * 8); } while (0)
    const int nlo = cur >= 8 ? cur - 8 : 0;
    int dA = nlo, dB = (nlo + 1 <= cur) ? nlo + 1 : 256;
    u32x4 kA, vA, kB, vB;
    ISSUE(kA, vA, dA); ISSUE(kB, vB, dB);
#pragma unroll
    for (int j = 0; j < 4; ++j) if (j < nct) {
        *(LAS u32x4*)(lds + L_KC + j * 8192 + wid * 1024 + lane * 16) = kcr[j];
        *(LAS u32x4*)(lds + L_VC + j * 8192 + wid * 1024 + lane * 16) = vcr[j]; }
    __syncthreads();
    Sm st; sm_init(st);
    f32x16 p0, p1;
    for (int j = 0; j < nct; ++j) {
        qkt(p0, p1, lds + L_KC + j * 8192, qr, r32, hi, slope2 * (float)(1024 * j + 31 - tq) - st.mref, 16.0f * slope2);
        mask_kv<true>(p0, p1, (tq - 31 - 1024 * j) >> 4, hi);
        tile_update(st, p0, p1, lds + L_VC + j * 8192, wsf, lane, r32, hi);
    }
    sm_finish(st, g_cmp, wsf, r32, hi);
    {
        const float mc = st.mref; const float lt = xadd32(st.l); const float invl = lt > 0.f ? 1.0f / lt : 0.f;
#pragma unroll
        for (int i = 0; i < 8; ++i) impw[i * 64 + lane] = 0.f;
        LDS_FENCE();
        LAS float* irow = impw + (r32 >> 2) * 64;
        for (int j = 0; j < nct; ++j) {
            qkt(p0, p1, lds + L_KC + j * 8192, qr, r32, hi, slope2 * (float)(1024 * j + 31 - tq) - mc, 16.0f * slope2);
            mask_kv<true>(p0, p1, (tq - 31 - 1024 * j) >> 4, hi);
            float G[8], Lst[8];
#pragma unroll
            for (int i = 0; i < 4; ++i) {
                float e0 = __builtin_amdgcn_exp2f(p0[4 * i]), e1 = __builtin_amdgcn_exp2f(p0[4 * i + 1]), e2 = __builtin_amdgcn_exp2f(p0[4 * i + 2]), e3 = __builtin_amdgcn_exp2f(p0[4 * i + 3]);
                G[i] = ((e0 + e1) + (e2 + e3)) * invl; Lst[i] = e3 * invl;
                e0 = __builtin_amdgcn_exp2f(p1[4 * i]); e1 = __builtin_amdgcn_exp2f(p1[4 * i + 1]); e2 = __builtin_amdgcn_exp2f(p1[4 * i + 2]); e3 = __builtin_amdgcn_exp2f(p1[4 * i + 3]);
                G[4 + i] = ((e0 + e1) + (e2 + e3)) * invl; Lst[4 + i] = e3 * invl;
            }
#pragma unroll
            for (int i = 0; i < 8; ++i) { G[i] += dpp_x1(G[i]); G[i] += dpp_x2(G[i]); Lst[i] += dpp_x1(Lst[i]); Lst[i] += dpp_x2(Lst[i]); }
            if (h == 0) {
#pragma unroll
                for (int i = 0; i < 8; ++i) { const int n = 16 * j + (i >> 2) * 8 + 2 * (i & 3) + hi; irow[n] += G[i]; }
            }
            LDS_FENCE();
            if (h == 0) {
#pragma unroll
                for (int i = 0; i < 8; ++i) { const int n = 16 * j + (i >> 2) * 8 + 2 * (i & 3) + hi + 1; if (n < 64) irow[n] += Lst[i]; }
            }
            LDS_FENCE();
        }
        unsigned long long wm = 0ull;
        if (cur >= 8) {
            const unsigned long long forced = 1ull | (1ull << cur) | (1ull << (cur - 1));
            const int qw = lane >> 3, l8 = lane & 7;
            float v[8];
            { const f32x4 va = *(const LAS f32x4*)(impw + qw * 64 + l8 * 8), vb = *(const LAS f32x4*)(impw + qw * 64 + l8 * 8 + 4);
#pragma unroll
              for (int i = 0; i < 4; ++i) { v[i] = va[i]; v[4 + i] = vb[i]; } }
#pragma unroll
            for (int i = 0; i < 8; ++i) { const int n = l8 * 8 + i; v[i] = (n >= 1 && n <= cur - 2) ? v[i] : -1.0f; }
            unsigned long long msk = forced;
#pragma unroll 1
            for (int k = 0; k < 5; ++k) {
                float m = fmaxf(fmaxf(fmaxf(v[0], v[1]), fmaxf(v[2], v[3])), fmaxf(fmaxf(v[4], v[5]), fmaxf(v[6], v[7])));
                m = fmaxf(m, dpp_x1(m)); m = fmaxf(m, dpp_x2(m)); m = fmaxf(m, dpp_hm(m));
                int idx = 64;
#pragma unroll
                for (int i = 7; i >= 0; --i) idx = (v[i] == m) ? (l8 * 8 + i) : idx;
                idx = min(idx, dpp_ix1(idx)); idx = min(idx, dpp_ix2(idx)); idx = min(idx, dpp_ihm(idx));
                msk |= 1ull << idx;
#pragma unroll
                for (int i = 0; i < 8; ++i) v[i] = (l8 * 8 + i == idx) ? -2.0f : v[i];
            }
            if (l8 == 0) selm[wid * 8 + qw] = msk;
            wm = msk;
            wm |= __shfl_xor(wm, 8); wm |= __shfl_xor(wm, 16); wm |= __shfl_xor(wm, 32);
        } else {
            const unsigned long long msk = (1ull << (cur + 1)) - 1ull;
            if (lane < 8) selm[wid * 8 + lane] = msk;
            wm = msk;
        }
        if (lane == 0) wun[wid] = wm;
    }
    __syncthreads();
    unsigned ticket = 0u;
    if (tid == 0) ticket = __hip_atomic_fetch_add(qhead, 1u, __ATOMIC_RELAXED, __HIP_MEMORY_SCOPE_AGENT);
    unsigned long long uni = 0ull;
#pragma unroll
    for (int i = 0; i < 8; ++i) uni |= wun[i];
    const unsigned long long wmask = wun[wid];
    const unsigned long long mymask = selm[ql];
    LAS float* stgf = (LAS float*)(lds + L_KC) + wid * 2048;
    stage_acc<false>(st, stgf, r32, hi);
    {
        int wi = nlo + 2; unsigned long long rem = (dB & 256) ? (uni & ~1ull) : uni; int slot = 0; bool in_sel = false;
        sm_init(st);
#define NEXT_DESC(d) do { if (wi <= cur) { d = wi; ++wi; } else if (rem != 0ull) { d = __builtin_ctzll(rem) | 256; rem &= rem - 1ull; } else d = -1; } while (0)
#define COMMIT(kr, vr) do { *(LAS u32x4*)(lds + L_KS + slot * 8192 + wid * 1024 + lane * 16) = kr; *(LAS u32x4*)(lds + L_VS + slot * 8192 + wid * 1024 + lane * 16) = vr; } while (0)
#define COMPUTE(d) do { const int n = (d) & 255; const bool sel = ((d) & 256) != 0; \
            if (sel && !in_sel) { sm_finish(st, g_win, wsf, r32, hi); stage_acc<true>(st, stgf, r32, hi); sm_init(st); in_sel = true; } \
            if ((!sel && !(skip & 2)) || (sel && !(skip & 1) && ((wmask >> n) & 1ull))) { \
                const bool rowok = !sel || (((mymask >> n) & 1ull) != 0ull); \
                qkt(p0, p1, lds + L_KS + slot * 8192, qr, r32, hi, rowok ? slope2 * (float)(64 * n - tq) - st.mref : -INFINITY, slope2); \
                if (n == cur) mask_kv<true>(p0, p1, ql, hi); \
                else if (!sel && cur >= 8 && n == cur - 8) mask_kv<false>(p0, p1, ql, hi); \
                tile_update(st, p0, p1, lds + L_VS + slot * 8192, wsf, lane, r32, hi); } \
            slot ^= 1; } while (0)
        for (;;) {
            COMMIT(kA, vA); LBAR();
            { const int dc = dA; NEXT_DESC(dA); if (dA >= 0) ISSUE(kA, vA, dA); COMPUTE(dc); }
            if (dB < 0) break;
            COMMIT(kB, vB); LBAR();
            { const int dc = dB; NEXT_DESC(dB); if (dB >= 0) ISSUE(kB, vB, dB); COMPUTE(dc); }
            if (dA < 0) break;
        }
        sm_finish(st, g_slc, wsf, r32, hi); stage_acc<true>(st, stgf, r32, hi);
#undef NEXT_DESC
#undef COMMIT
#undef COMPUTE
    }
#undef ISSUE
    {
        LDS_FENCE();
        bf16_t* op = mixin + (rowb + t0 + wid * 8) * D + g * 256;
#pragma unroll
        for (int i = 0; i < 4; ++i) { const int piece = i * 64 + lane, tok = piece >> 5, o16 = piece & 31;
            const f32x4 v0 = *(const LAS f32x4*)(stgf + tok * 256 + o16 * 8), v1 = *(const LAS f32x4*)(stgf + tok * 256 + o16 * 8 + 4);
            u32x4 v; v.x = cvtpk(v0[0], v0[1]); v.y = cvtpk(v0[2], v0[3]); v.z = cvtpk(v1[0], v1[1]); v.w = cvtpk(v1[2], v1[3]);
            *(u32x4*)(op + (size_t)tok * D + o16 * 8) = v; }
    }
    if (tid == 0) *(LAS unsigned*)(lds + L_TK) = ticket;
    __syncthreads();
}
__device__ __forceinline__ void attn_phase(LAS unsigned char* lds, const bf16_t* z, const bf16_t* kcb, bf16_t* mixin, int skip, unsigned* qhead, bool with_pool, int part) {
    const bool per_xcd = part >= 0;
    const int bsel = part & 7;
    const unsigned n_att = per_xcd ? 128u : 1024u, n_pool = with_pool ? (per_xcd ? (unsigned)(NPOOL / BATCH) : (unsigned)NPOOL) : 0u;
    const unsigned first_dyn = per_xcd ? gridDim.x / 8u : gridDim.x;
    unsigned u = per_xcd ? (unsigned)(part >> 3) : blockIdx.x;
    while (u < n_att + n_pool) {
        if (u < n_att) {
            int b_, g_, qblk;
            if (per_xcd) { b_ = bsel; g_ = (int)(u & 1u) ^ 1; qblk = 63 - (int)(u >> 1); }
            else { const int bgi = (int)(u & 15u); b_ = bgi >> 1; g_ = bgi & 1; qblk = 63 - (int)(u >> 4); }
            attn_unit(lds, z, kcb, mixin, b_, g_, qblk, skip, qhead);
        } else {
            unsigned ticket = 0u;
            if (threadIdx.x == 0) ticket = __hip_atomic_fetch_add(qhead, 1u, __ATOMIC_RELAXED, __HIP_MEMORY_SCOPE_AGENT);
            pool_item(z, mixin, (int)(u - n_att) + (per_xcd ? bsel * (NPOOL / BATCH) : 0));
            if (threadIdx.x == 0) *(LAS unsigned*)(lds + L_TK) = ticket;
            __syncthreads();
        }
        const unsigned nt = *(const LAS unsigned*)(lds + L_TK);
        __syncthreads();
        u = first_dyn + nt;
    }
}
}

__device__ __forceinline__ void final_norm(const bf16_t* xb, float* out, const float* gain) {
    int tid = threadIdx.x; asm volatile("" : "+v"(tid));
    const int lane = tid & 63, wave = tid >> 6;
    const int gw = blockIdx.x * NWAVES + wave, NGW = gridDim.x * NWAVES;
    for (int m = gw; m < M; m += NGW) {
        const u32x2* xr = (const u32x2*)(xb + (size_t)m * D) + lane; f32x4* orow = (f32x4*)(out + (size_t)m * D) + lane; const f32x4* gr = (const f32x4*)gain + lane;
        f32x4 v[4]; float s = 0.f;
#pragma unroll
        for (int j = 0; j < 4; ++j) { const u32x2 pv = xr[64 * j];
            v[j] = (f32x4){__builtin_bit_cast(float, pv.x << 16), __builtin_bit_cast(float, pv.x & 0xffff0000u), __builtin_bit_cast(float, pv.y << 16), __builtin_bit_cast(float, pv.y & 0xffff0000u)};
            s += (v[j].x * v[j].x + v[j].y * v[j].y) + (v[j].z * v[j].z + v[j].w * v[j].w); }
        const float rs = 1.0f / sqrtf(wave_sum(s) * (1.0f / D) + EPS);
#pragma unroll
        for (int j = 0; j < 4; ++j) orow[64 * j] = v[j] * rs * gr[64 * j];
    }
}

#define XB_TMO      128
#define XB_XCNT(j)  (256  + 64 * (j))
#define XB_XSUB(j)  (1280 + 64 * (j))
#define XB_XGEN(j)  (2304 + 64 * (j))
#define XB_TOP      3328
#define XB_TOPGEN   3392
#define XCD_BAR_WORDS 3456
#define XB_SPIN_CAP (1u << 18)
__device__ __forceinline__ unsigned xb_ld(unsigned* p)              { return __hip_atomic_load(p, __ATOMIC_RELAXED, __HIP_MEMORY_SCOPE_AGENT); }
__device__ __forceinline__ unsigned xb_add(unsigned* p, unsigned v) { return __hip_atomic_fetch_add(p, v, __ATOMIC_RELAXED, __HIP_MEMORY_SCOPE_AGENT); }
__device__ __forceinline__ unsigned xb_xcc_id() { return (unsigned)__builtin_amdgcn_s_getreg((3 << 11) | 20) & 0xFu; }
#define XB_SPIN(cond, bar) do { unsigned _sp = 0; while (cond) { __builtin_amdgcn_s_sleep(1); \
    if ((++_sp & 255u) == 0u) { if (xb_ld(&(bar)[XB_TMO])) break; if (_sp > XB_SPIN_CAP) { atomicAdd(&(bar)[XB_TMO], 1u); break; } } } } while (0)
struct XcdBarrier { unsigned* bar; unsigned x; volatile LAS unsigned* st; };
__device__ __forceinline__ XcdBarrier xcd_barrier_post(unsigned* bar, volatile LAS unsigned* st) {
    XcdBarrier b; b.bar = bar; b.x = xb_xcc_id(); b.st = st;
    if (threadIdx.x == 0) st[2] = xb_add(&bar[XB_XCNT(b.x)], 1u);
    return b;
}
__device__ __forceinline__ void xcd_barrier_complete(unsigned* bar, unsigned x, unsigned& nloc, unsigned& nx) {
    const unsigned G = gridDim.x * gridDim.y * gridDim.z;
    unsigned sum, cnt, mine, sp = 0u;
    for (;;) {
        sum = 0u; cnt = 0u; mine = 0u;
#pragma unroll
        for (unsigned j = 0; j < 16; ++j) { const unsigned c = xb_ld(&bar[XB_XCNT(j)]); sum += c; cnt += (c > 0u) ? 1u : 0u; mine = (j == x) ? c : mine; }
        if (sum == G) break;
        __builtin_amdgcn_s_sleep(1);
        if ((++sp & 255u) == 0u) { if (xb_ld(&bar[XB_TMO])) break; if (sp > XB_SPIN_CAP) { atomicAdd(&bar[XB_TMO], 1u); break; } }
    }
    nloc = mine > 0u ? mine : 1u; nx = cnt > 0u ? cnt : 1u;
}
__device__ __forceinline__ void xcd_barrier(const XcdBarrier& b) {
    asm volatile("s_waitcnt vmcnt(0)" ::: "memory");
    __syncthreads();
    if (threadIdx.x == 0) {
        unsigned* bar = b.bar;
        __builtin_amdgcn_s_waitcnt(0);
        unsigned nloc = b.st[0], nx = b.st[1];
        if (nloc == 0u) { xcd_barrier_complete(bar, b.x, nloc, nx); b.st[0] = nloc; b.st[1] = nx; }
        const unsigned old = xb_add(&bar[XB_XSUB(b.x)], 1u);
        const unsigned gen = old / nloc;
        if (old + 1u == (gen + 1u) * nloc) {
            __builtin_amdgcn_fence(__ATOMIC_RELEASE, "agent");
            asm volatile("s_waitcnt vmcnt(0)" ::: "memory");
            const unsigned og = xb_add(&bar[XB_TOP], 1u);
            const unsigned tg = og / nx;
            if (og + 1u == (tg + 1u) * nx) xb_add(&bar[XB_TOPGEN], 1u);
            else XB_SPIN(xb_ld(&bar[XB_TOPGEN]) == tg, bar);
            __builtin_amdgcn_fence(__ATOMIC_ACQUIRE, "agent");
            xb_add(&bar[XB_XGEN(b.x)], 1u);
            asm volatile("s_waitcnt vmcnt(0)" ::: "memory");
        } else {
            XB_SPIN(xb_ld(&bar[XB_XGEN(b.x)]) == gen, bar);
            __builtin_amdgcn_fence(__ATOMIC_ACQUIRE, "agent");
            asm volatile("s_waitcnt vmcnt(0)" ::: "memory");
        }
    }
    __syncthreads();
}

__device__ __forceinline__ void xcd_barrier_local(const XcdBarrier& b) {
    asm volatile("s_waitcnt vmcnt(0)" ::: "memory");
    __syncthreads();
    if (threadIdx.x == 0) {
        unsigned* bar = b.bar;
        __builtin_amdgcn_s_waitcnt(0);
        const unsigned nloc = b.st[0];
        const unsigned old = xb_add(&bar[XB_XSUB(b.x)], 1u);
        const unsigned gen = old / nloc;
        if (old + 1u == (gen + 1u) * nloc) xb_add(&bar[XB_XGEN(b.x)], 1u);
        else XB_SPIN(xb_ld(&bar[XB_XGEN(b.x)]) == gen, bar);
        __builtin_amdgcn_fence(__ATOMIC_ACQUIRE, "agent");
        asm volatile("s_waitcnt vmcnt(0)" ::: "memory");
    }
    __syncthreads();
}
__device__ __forceinline__ void xcd_virtual_id(const XcdBarrier& b, int& vid, bool& local_ok) {
    if (threadIdx.x == 0) {
        const unsigned G = gridDim.x; bool ok = (G % 8u) == 0u;
#pragma unroll
        for (unsigned j = 0; j < 16; ++j) { const unsigned c = xb_ld(&b.bar[XB_XCNT(j)]); ok = ok && (c == (j < 8u ? G / 8u : 0u)); }
        ok = ok && b.x < 8u && b.st[2] < G / 8u && xb_ld(&b.bar[XB_TMO]) == 0u;
        b.st[3] = ok ? 1u : 0u; if (ok) b.st[2] = b.st[2] * 8u + b.x; else b.st[2] = blockIdx.x;
    }
    __syncthreads();
    vid = __builtin_amdgcn_readfirstlane((int)b.st[2]); local_ok = __builtin_amdgcn_readfirstlane((int)b.st[3]) != 0;
    __syncthreads();
}

constexpr int LDS_BYTES = 147456 + 256;
constexpr int N_PHASES = 2 + 8 * DEPTH;

__global__ void __launch_bounds__(NWAVES * 64, 2) fwd_kernel(Args args) {
    extern __shared__ __attribute__((aligned(16))) unsigned char lds_raw[];
    LAS unsigned char* lds = (LAS unsigned char*)lds_raw;
    cg::grid_group grid = cg::this_grid();
    const int G = gridDim.x;
    unsigned char* ws = args.ws;
    float* xres = args.out;
    float* ssq = (float*)(ws + WS_SSQ);
    bf16_t* xb = (bf16_t*)(ws + WS_XB);
    bf16_t* act = (bf16_t*)(ws + WS_BIG);
    bf16_t* zb = (bf16_t*)(ws + WS_Z);
    bf16_t* mixin = (bf16_t*)(ws + WS_MIX);
    bf16_t* kcb = (bf16_t*)(ws + WS_KC);
    unsigned* barw = (unsigned*)(ws + WS_CTL);
    volatile LAS unsigned* bst = (volatile LAS unsigned*)(lds + LDS_BYTES - 64)      ;
    if (threadIdx.x < 4) bst[threadIdx.x] = 0u;
    __syncthreads();
    XcdBarrier xbar; xbar.bar = barw; xbar.x = 0; xbar.st = bst;
#ifndef DUPMASK
#define DUPMASK 0
#endif
    int ph = args.ph_lo; const int hi_ph = args.ph_hi;
    int vid = (int)blockIdx.x; bool local_ok = false;
    if (args.ph_lo < 0) grid.sync();
    if (hi_ph - ph > 1) xbar = xcd_barrier_post(barw, bst);
    if (ph == 0) {
        prologue(args, lds, G);
        if (args.dup & 8192) { __syncthreads(); prologue(args, lds, G); }
        ph = 1;
        if (ph < hi_ph) { xcd_barrier(xbar); xcd_virtual_id(xbar, vid, local_ok); }
    }
    bool need_bar = false;
    for (; ph < hi_ph && ph < N_PHASES - 1; ++ph) {
        const int l = (ph - 1) >> 3, k = (ph - 1) & 7;
        if (need_bar) { if (local_ok && args.dup == 0) xcd_barrier_local(xbar); else { xcd_barrier(xbar); if (args.dup & 1024) xcd_barrier(xbar); } }
        need_bar = true;
        const unsigned char* lw = ws + WS_W + (size_t)l * LW_STRIDE;
        const int reps = ((args.dup >> k) & 1) ? 2 : 1;
        for (int rep = 0; rep < reps; ++rep) {
        pg8::StaticOrder S;
        if (k == 0 || k == 6) {
            pg8::Gemm g{xb, (const bf16_t*)(lw + (k == 0 ? LW_F1 : LW_F2)), M, 2 * FF, D, 0}; S.init(M, 2 * FF, G, vid);
            pg8::EpiSwiGLU E{act, ssq};
            pg8::gemm_phase<pg8::EpiSwiGLU>(lds, g, S, E);
        } else if (k == 1 || k == 7) {
            pg8::Gemm g{act, (const bf16_t*)(lw + (k == 1 ? LW_D1 : LW_D2)), M, D, FF, PAD_ACT * 2}; S.init(M, D, G, vid);
            pg8::EpiResid E{xb, ssq, rep == 0 ? 0.5f : 0.0f};
            pg8::gemm_phase<pg8::EpiResid>(lds, g, S, E);
        } else if (k == 2) {
            pg8::Gemm g{xb, (const bf16_t*)(lw + LW_IN), M, NZ, D, 0}; S.init(M, NZ, G, vid);
            pg8::EpiZ E{zb, ssq};
            pg8::gemm_phase<pg8::EpiZ>(lds, g, S, E);
        } else if (k == 3) {
            compress_phase(lds, zb, lw, kcb, local_ok ? vid : -1);
        } else if (k == 4) {
            if (rep == 0 || (args.dup & 512)) att::attn_phase(lds, zb, kcb, mixin, (reps > 1 && rep == 0) ? ((args.dup >> 11) & 3) : 0, barw + XCD_BAR_WORDS + ((l * 2 + rep) * 8 + (local_ok ? (vid & 7) : 0)) * 64, rep == 0 || (args.dup & 256), local_ok ? vid : -1);
        } else {
            pg8::Gemm g{mixin, (const bf16_t*)(lw + LW_OUT), M, D, D, PAD_MIX * 2}; S.init(M, D, G, vid);
            pg8::EpiResid E{xb, ssq, rep == 0 ? 1.0f : 0.0f};
            pg8::gemm_phase<pg8::EpiResid>(lds, g, S, E);
        }
        if (reps > 1 && rep == 0) xcd_barrier(xbar);
        }
    }
    if (ph < hi_ph) { if (need_bar) xcd_barrier(xbar); final_norm(xb, xres, args.in[20]); }
}

#ifndef MK_MULTI
#define MK_MULTI 0
#endif
extern "C" void kernel_launch(void* const* d_in, const int* in_sizes, int n_in, void* d_out, int out_size, void* d_ws, size_t ws_size, hipStream_t stream) {
    static int grid = 0;
    if (grid == 0) {
        if (n_in != 21 || in_sizes[0] != M * D || out_size != M * D || ws_size < WS_END) {
            fprintf(stderr, "kernel_launch: unexpected problem: n_in %d in0 %d out %d ws %zu (need %zu)\n", n_in, n_in > 0 ? in_sizes[0] : -1, out_size, ws_size, (size_t)WS_END); grid = -1; return; }
        int dev = 0, cus = 0, per_cu = 0;
        hipGetDevice(&dev);
        hipDeviceGetAttribute(&cus, hipDeviceAttributeMultiprocessorCount, dev);
        if (hipFuncSetAttribute((const void*)fwd_kernel, hipFuncAttributeMaxDynamicSharedMemorySize, LDS_BYTES) != hipSuccess) { fprintf(stderr, "kernel_launch: hipFuncSetAttribute failed\n"); grid = -1; return; }
        if (hipOccupancyMaxActiveBlocksPerMultiprocessor(&per_cu, (const void*)fwd_kernel, NWAVES * 64, LDS_BYTES) != hipSuccess || per_cu < 1) { fprintf(stderr, "kernel_launch: occupancy query says %d\n", per_cu); per_cu = 1; }
        (void)hipGetLastError();
        if (per_cu > 1) per_cu = 1;
        grid = cus * per_cu;
        fprintf(stderr, "kernel_launch: grid %d (cus %d x %d)\n", grid, cus, per_cu);
    }
    if (grid < 0) return;
    if (hipMemsetAsync((char*)d_ws + WS_CTL, 0, CTL_ZERO_BYTES, stream) != hipSuccess) { fprintf(stderr, "kernel_launch: hipMemsetAsync of the control words failed\n"); return; }
    Args a{};
    for (int i = 0; i < 21; ++i) a.in[i] = (const float*)d_in[i];
    a.out = (float*)d_out; a.ws = (unsigned char*)d_ws; a.dup = DUPMASK;
#if MK_MULTI
    for (int ph = 0; ph < N_PHASES; ++ph) { a.ph_lo = ph; a.ph_hi = ph + 1; hipLaunchKernelGGL(fwd_kernel, dim3(grid), dim3(NWAVES * 64), LDS_BYTES, stream, a); }
#else
    a.ph_lo = 0; a.ph_hi = N_PHASES;
    void* kargs[] = {&a};
    hipError_t e = hipLaunchCooperativeKernel((const void*)fwd_kernel, dim3(grid), dim3(NWAVES * 64), kargs, LDS_BYTES, stream);
    if (e != hipSuccess) fprintf(stderr, "kernel_launch: cooperative launch failed: %s (grid %d)\n", hipGetErrorString(e), grid);
#endif
}
```

```cpp
#include <hip/hip_runtime.h>
#include <hip/hip_cooperative_groups.h>
#include <cstdio>
#include <cstdint>
namespace cg = cooperative_groups;

#define LAS __attribute__((address_space(3)))
typedef unsigned short bf16_t;
typedef short bf16x8 __attribute__((ext_vector_type(8)));
typedef short s16x4 __attribute__((ext_vector_type(4)));
typedef float f32x2 __attribute__((ext_vector_type(2)));
typedef float f32x4 __attribute__((ext_vector_type(4)));
typedef float f32x16 __attribute__((ext_vector_type(16)));
typedef unsigned u32x2 __attribute__((ext_vector_type(2)));
typedef unsigned u32x4 __attribute__((ext_vector_type(4)));
typedef __bf16 bf16x2_t __attribute__((ext_vector_type(2)));

constexpr int BATCH = 8, T = 4096, D = 1024, FF = 2816, DEPTH = 4;
constexpr int M = BATCH * T;
constexpr int NZ = 2048;
constexpr int INW = 1816;
constexpr int ZQ = 0, ZKC = 512, ZVC = 640, ZKS = 768, ZVS = 896, ZKW = 1024, ZVW = 1152, ZG = 1280, ZU = 1304;
constexpr float EPS = 1e-6f;
constexpr float LOG2E = 1.4426950408889634f;
constexpr float C2 = 0.125f * LOG2E;
constexpr int NWAVES = 8;

constexpr size_t MiB = 1u << 20;
constexpr size_t LW_F1 = 0;
constexpr size_t LW_D1 = LW_F1 + (size_t)2 * FF * D * 2;
constexpr size_t LW_F2 = LW_D1 + (size_t)D * FF * 2;
constexpr size_t LW_D2 = LW_F2 + (size_t)2 * FF * D * 2;
constexpr size_t LW_IN = LW_D2 + (size_t)D * FF * 2;
constexpr size_t LW_OUT = LW_IN + (size_t)NZ * D * 2;
constexpr size_t LW_CK1 = LW_OUT + (size_t)D * D * 2;
constexpr size_t LW_CV1 = LW_CK1 + (size_t)128 * 2048 * 2;
constexpr size_t LW_CK2 = LW_CV1 + (size_t)128 * 2048 * 2;
constexpr size_t LW_CV2 = LW_CK2 + (size_t)64 * 128 * 2;
constexpr size_t LW_CBK = LW_CV2 + (size_t)64 * 128 * 2;
constexpr size_t LW_CBV = LW_CBK + 512;
constexpr size_t LW_END = LW_CBV + 512;
constexpr size_t LW_STRIDE = 41 * MiB;
static_assert(LW_END <= LW_STRIDE, "layer weight block");
constexpr size_t WS_W = 0;
constexpr size_t WS_SSQ = WS_W + DEPTH * LW_STRIDE;
constexpr size_t WS_KC = WS_SSQ + (size_t)16 * M * 4;
constexpr size_t WS_XB = WS_KC + 1 * MiB;
constexpr size_t WS_BIG = WS_XB + (size_t)M * D * 2;
constexpr size_t ARENA_B = 24 * MiB, ARENA_E = ARENA_B / 2;
constexpr size_t PAD_ACT = ARENA_E - (size_t)T * FF, PAD_Z = ARENA_E - (size_t)T * NZ, PAD_MIX = ARENA_E - (size_t)T * D;
constexpr size_t WS_Z = WS_BIG, WS_MIX = WS_BIG + 16 * MiB;
static_assert((size_t)T * FF * 2 <= ARENA_B && (size_t)T * NZ * 2 <= 16 * MiB && (size_t)T * D * 2 <= 8 * MiB && BATCH * ARENA_B <= 192 * MiB, "arenas");
constexpr size_t WS_CTL = WS_BIG + (size_t)192 * MiB;
constexpr size_t WS_END = WS_CTL + 1 * MiB;
constexpr size_t CTL_ZERO_BYTES = 32768;
static_assert((size_t)M * FF * 2 <= 192 * MiB && WS_END <= (size_t)512 * MiB, "d_ws map");

__device__ __forceinline__ float xadd16(float v) { const unsigned u = __builtin_bit_cast(unsigned, v); auto rr = __builtin_amdgcn_permlane16_swap(u, u, false, false); return __builtin_bit_cast(float, (unsigned)rr[0]) + __builtin_bit_cast(float, (unsigned)rr[1]); }
__device__ __forceinline__ float xadd32(float v) { const unsigned u = __builtin_bit_cast(unsigned, v); auto rr = __builtin_amdgcn_permlane32_swap(u, u, false, false); return __builtin_bit_cast(float, (unsigned)rr[0]) + __builtin_bit_cast(float, (unsigned)rr[1]); }
__device__ __forceinline__ float xmax32(float v) { const unsigned u = __builtin_bit_cast(unsigned, v); auto rr = __builtin_amdgcn_permlane32_swap(u, u, false, false); return fmaxf(__builtin_bit_cast(float, (unsigned)rr[0]), __builtin_bit_cast(float, (unsigned)rr[1])); }
namespace pg8 {
constexpr int BM = 256, BK = 64, HALF = 128, HTB = HALF * BK * 2, STAGE_BYTES = 8 * HTB, NXCD = 8, WGM = 4;
__host__ __device__ __forceinline__ int lds_byte(int r, int c) { const int st = (r >> 4) * 2 + (c >> 5), rr = r & 15, cc = c & 31, ob = rr * 64 + cc * 2; return st * 1024 + (ob ^ (((ob >> 9) & 1) << 5)); }
__host__ __device__ __forceinline__ void stage_rc(int b, int& R, int& C) { const int st = b / 1024, sb = b % 1024, swz = sb ^ (((sb >> 9) & 1) << 5); R = (st >> 1) * 16 + swz / 64; C = (st & 1) * 32 + (swz % 64) / 2; }
__host__ __device__ __forceinline__ int perm32(int rho) { const int n = rho >> 4, i = rho & 15; return 8 * (i >> 2) + 4 * n + (i & 3); }
struct Unit { int pm, pn; };
struct Gemm { const bf16_t* A; const bf16_t* Bt; int M, N, K; size_t padA; };
struct StaticOrder {
    int nM, nN, nwg, G, c;
    __host__ __device__ void init(int M_, int N_, int G_, int c_) { nM = M_ / BM; nN = N_ / BM; nwg = nM * nN; G = G_; c = c_; }
    __host__ __device__ bool next(int i, Unit& u) const {
        const long L = (long)i * G + c; if (L >= nwg) return false;
        int wgid = (int)L; { const int q = nwg / NXCD, r = nwg % NXCD, xcd = wgid % NXCD, off = wgid / NXCD; wgid = (xcd < r ? xcd * (q + 1) : r * (q + 1) + (xcd - r) * q) + off; }
        const int nig = WGM * nN, gid = wgid / nig, fm = gid * WGM, gsz = (nM - fm) < WGM ? (nM - fm) : WGM;
        u.pm = fm + ((wgid % nig) % gsz); u.pn = (wgid % nig) / gsz; return true;
    }
};
__device__ __forceinline__ unsigned cvt_pk_bf16(float lo, float hi) { unsigned r; asm volatile("v_cvt_pk_bf16_f32 %0, %1, %2" : "=v"(r) : "v"(lo), "v"(hi)); return r; }

constexpr int RS_OFF = 131072;
__device__ __forceinline__ float row_rstd(const LAS unsigned char* lds, int row_local, int fq) {
    const f32x4 pv = *(const LAS f32x4*)(lds + RS_OFF + row_local * 64 + fq * 16);
    float s = (pv[0] + pv[1]) + (pv[2] + pv[3]);
    s = xadd16(s); s = xadd32(s);
    return __builtin_amdgcn_rsqf(s * (1.0f / D) + EPS);
}
struct EpiSwiGLU {
    static constexpr bool PERM = true, RSTD = true;
    bf16_t* O; const float* ssq;
    __device__ __forceinline__ void operator()(const f32x4 (&acc)[2][2][4][2], const Unit& u, int wr, int wc, int fr, int fq, const LAS unsigned char* lds) const {
        const int row0 = u.pm * BM + wr * 64 + fr, col0 = u.pn * HALF + wc * 32 + 8 * fq;
        float rsv[2][4];
#pragma unroll
        for (int ai = 0; ai < 2; ++ai)
#pragma unroll
            for (int m = 0; m < 4; ++m) rsv[ai][m] = row_rstd(lds, wr * 64 + fr + ai * HALF + m * 16, fq);
        asm volatile("s_waitcnt lgkmcnt(0)\n\ts_barrier" ::: "memory");
#pragma unroll
        for (int ai = 0; ai < 2; ++ai)
#pragma unroll
            for (int m = 0; m < 4; ++m) {
                const int row = row0 + ai * HALF + m * 16; const float rs = rsv[ai][m];
                float a[8];
                const float c1 = -rs * LOG2E, rs2 = rs * rs;
#pragma unroll
                for (int n = 0; n < 2; ++n)
#pragma unroll
                    for (int j = 0; j < 4; ++j) { const float ag = acc[ai][0][m][n][j], au = acc[ai][1][m][n][j];
                        a[n * 4 + j] = (ag * au) * (rs2 * __builtin_amdgcn_rcpf(1.0f + __builtin_amdgcn_exp2f(ag * c1))); }
                u32x4 w; w.x = cvt_pk_bf16(a[0], a[1]); w.y = cvt_pk_bf16(a[2], a[3]); w.z = cvt_pk_bf16(a[4], a[5]); w.w = cvt_pk_bf16(a[6], a[7]);
                *(u32x4*)(O + (size_t)row * FF + (size_t)(row >> 12) * PAD_ACT + col0) = w;
            }
    }
};
struct EpiZ {
    static constexpr bool PERM = true, RSTD = true;
    bf16_t* O; const float* ssq;
    __device__ __forceinline__ void operator()(const f32x4 (&acc)[2][2][4][2], const Unit& u, int wr, int wc, int fr, int fq, const LAS unsigned char* lds) const {
        const int row0 = u.pm * BM + wr * 64 + fr, colt = u.pn * BM, col0 = colt + wc * 32 + 8 * fq;
        const float sc = (colt < 512) ? C2 : 1.0f;
        float rsv[2][4];
#pragma unroll
        for (int ai = 0; ai < 2; ++ai)
#pragma unroll
            for (int m = 0; m < 4; ++m) rsv[ai][m] = row_rstd(lds, wr * 64 + fr + ai * HALF + m * 16, fq) * sc;
        asm volatile("s_waitcnt lgkmcnt(0)\n\ts_barrier" ::: "memory");
#pragma unroll
        for (int ai = 0; ai < 2; ++ai)
#pragma unroll
            for (int m = 0; m < 4; ++m) {
                const int row = row0 + ai * HALF + m * 16; const float rs = rsv[ai][m];
#pragma unroll
                for (int bj = 0; bj < 2; ++bj) { const f32x4 v0 = acc[ai][bj][m][0] * rs, v1 = acc[ai][bj][m][1] * rs;
                    u32x4 w; w.x = cvt_pk_bf16(v0[0], v0[1]); w.y = cvt_pk_bf16(v0[2], v0[3]); w.z = cvt_pk_bf16(v1[0], v1[1]); w.w = cvt_pk_bf16(v1[2], v1[3]);
                    *(u32x4*)(O + (size_t)row * NZ + (size_t)(row >> 12) * PAD_Z + col0 + bj * HALF) = w; }
            }
    }
};
struct EpiResid {
    static constexpr bool PERM = true, RSTD = false;
    bf16_t* xb; float* ssq; float alpha;
    __device__ __forceinline__ void operator()(const f32x4 (&acc)[2][2][4][2], const Unit& u, int wr, int wc, int fr, int fq, const LAS unsigned char*) const {
        const int row0 = u.pm * BM + wr * 64 + fr, col0 = u.pn * BM + wc * 32 + 8 * fq;
#pragma unroll
        for (int ai = 0; ai < 2; ++ai) {
            u32x4 pre[4][2];
#pragma unroll
            for (int m = 0; m < 4; ++m)
#pragma unroll
                for (int bj = 0; bj < 2; ++bj) pre[m][bj] = *(const u32x4*)(xb + (size_t)(row0 + ai * HALF + m * 16) * D + col0 + bj * HALF);
#pragma unroll
            for (int m = 0; m < 4; ++m) {
                const int row = row0 + ai * HALF + m * 16; const size_t off = (size_t)row * D + col0; float ss = 0.f;
#pragma unroll
                for (int bj = 0; bj < 2; ++bj) { const u32x4 pv = pre[m][bj];
                    const f32x4 x0 = {__builtin_bit_cast(float, pv.x << 16), __builtin_bit_cast(float, pv.x & 0xffff0000u), __builtin_bit_cast(float, pv.y << 16), __builtin_bit_cast(float, pv.y & 0xffff0000u)};
                    const f32x4 x1 = {__builtin_bit_cast(float, pv.z << 16), __builtin_bit_cast(float, pv.z & 0xffff0000u), __builtin_bit_cast(float, pv.w << 16), __builtin_bit_cast(float, pv.w & 0xffff0000u)};
                    const f32x4 o0 = x0 + acc[ai][bj][m][0] * alpha, o1 = x1 + acc[ai][bj][m][1] * alpha;
                    ss += ((o0[0] * o0[0] + o0[1] * o0[1]) + (o0[2] * o0[2] + o0[3] * o0[3])) + ((o1[0] * o1[0] + o1[1] * o1[1]) + (o1[2] * o1[2] + o1[3] * o1[3]));
                    u32x4 w; w.x = cvt_pk_bf16(o0[0], o0[1]); w.y = cvt_pk_bf16(o0[2], o0[3]); w.z = cvt_pk_bf16(o1[0], o1[1]); w.w = cvt_pk_bf16(o1[2], o1[3]);
                    *(u32x4*)(xb + off + bj * HALF) = w; }
                ss = xadd16(ss); ss = xadd32(ss);
                if (fq == 0) ssq[(size_t)row * 16 + u.pn * 4 + wc] = ss;
            }
            asm volatile("" ::: "memory");
        }
    }
};

template <class Epi, bool ALIGN_EPI = true>
__device__ __forceinline__ void gemm_phase(LAS unsigned char* lds, const Gemm g, const StaticOrder& S, const Epi& E) {
    int tid = threadIdx.x; asm volatile("" : "+v"(tid));
    const int wid = __builtin_amdgcn_readfirstlane(tid >> 6), lane = tid & 63, wr = wid >> 2, wc = wid & 3, fr = lane & 15, fq = lane >> 4;
    const int K = g.K, nt = K / BK;
    unsigned voffA[2], voffB[2];
#pragma unroll
    for (int i = 0; i < 2; ++i) { int R, C; stage_rc(tid * 16 + i * 8192, R, C); const int Rb = Epi::PERM ? ((R & ~31) + perm32(R & 31)) : R;
        voffA[i] = (unsigned)(R * K + C) * 2u; voffB[i] = (unsigned)(Rb * K + C) * 2u; }
    const size_t kstep = (size_t)(BK * 2);
    const size_t hstep = (size_t)HALF * K * 2;
    const size_t tstep = 2 * hstep;
    const unsigned ldsw = (unsigned)wid * 1024u;
    const int aoff = lds_byte(wr * 64 + fr, fq * 8), boff = lds_byte(wc * 32 + fr, fq * 8);
#define PG8_SA(b, h) (((b) * 2 + (h)) * HTB)
#define PG8_SB(b, h) ((4 + (b) * 2 + (h)) * HTB)
#define PG8_STAGE(bufoff, gbase, voff) do { _Pragma("unroll") for (int _i = 0; _i < 2; ++_i) \
        __builtin_amdgcn_global_load_lds((const unsigned*)((const char*)(gbase) + (voff)[_i]), (LAS unsigned*)(lds + (bufoff) + ldsw + _i * 8192), 16, 0, 0); } while (0)
#define PG8_LDA(dst, b, h) do { _Pragma("unroll") for (int m = 0; m < 4; ++m) _Pragma("unroll") for (int k = 0; k < 2; ++k) dst[m][k] = *(const LAS bf16x8*)(lds + PG8_SA(b, h) + aoff + m * 2048 + k * 1024); } while (0)
#define PG8_LDB(dst, b, h) do { _Pragma("unroll") for (int n = 0; n < 2; ++n) _Pragma("unroll") for (int k = 0; k < 2; ++k) dst[n][k] = *(const LAS bf16x8*)(lds + PG8_SB(b, h) + boff + n * 2048 + k * 1024); } while (0)
#define PG8_MMA(ai, bj, At, Bt) do { __builtin_amdgcn_s_setprio(1); _Pragma("unroll") for (int m = 0; m < 4; ++m) _Pragma("unroll") for (int n = 0; n < 2; ++n) _Pragma("unroll") for (int k = 0; k < 2; ++k) \
        acc[ai][bj][m][n] = __builtin_amdgcn_mfma_f32_16x16x32_bf16(Bt[n][k], At[m][k], acc[ai][bj][m][n], 0, 0, 0); __builtin_amdgcn_s_setprio(0); } while (0)
#define PG8_WAIT_V(n) asm volatile("s_waitcnt vmcnt(" #n ")" ::: "memory")
#define PG8_WAIT_L(n) asm volatile("s_waitcnt lgkmcnt(" #n ")" ::: "memory")
#define PG8_BAR __builtin_amdgcn_s_barrier()
#define PG8_SCHED __builtin_amdgcn_sched_barrier(0)
    Unit cur, nxt; int ui = 0;
    if (!S.next(0, cur)) return;
    f32x4 acc[2][2][4][2];
#pragma unroll
    for (int a = 0; a < 2; ++a)
#pragma unroll
        for (int b = 0; b < 2; ++b)
#pragma unroll
            for (int m = 0; m < 4; ++m)
#pragma unroll
                for (int n = 0; n < 2; ++n) acc[a][b][m][n] = (f32x4){0.f, 0.f, 0.f, 0.f};
    bf16x8 At[4][2], B0[2][2], B1[2][2];
    const char* cA = (const char*)g.A + (size_t)cur.pm * tstep + (size_t)(cur.pm >> 4) * g.padA; const char* cB = (const char*)g.Bt + (size_t)cur.pn * tstep;
    PG8_STAGE(PG8_SB(0, 0), cB, voffB); PG8_STAGE(PG8_SB(0, 1), cB + hstep, voffB); PG8_STAGE(PG8_SA(0, 0), cA, voffA); PG8_STAGE(PG8_SA(0, 1), cA + hstep, voffA);
    if (wr == 1) PG8_BAR;
    PG8_WAIT_V(2); PG8_BAR;
    PG8_STAGE(PG8_SB(1, 0), cB + kstep, voffB); PG8_STAGE(PG8_SA(1, 0), cA + kstep, voffA); PG8_STAGE(PG8_SB(1, 1), cB + hstep + kstep, voffB);
    PG8_WAIT_V(6); PG8_BAR;
#define PG8_RS_DMA(unit) do { if constexpr (Epi::RSTD) { \
        const unsigned loff_ = ldsw + (unsigned)((fq << 4) + fr) * 16u; \
        const char* rb0_ = (const char*)E.ssq + (size_t)(unit).pm * (BM * 64); const char* rb1_ = rb0_ + 8192; \
        const unsigned m0a_ = (unsigned)(__SIZE_TYPE__)(lds + RS_OFF) + ldsw, m0b_ = m0a_ + 8192u; unsigned keep_; \
        asm volatile("s_mov_b32 %0, m0\n\ts_mov_b32 m0, %2\n\ts_nop 0\n\tglobal_load_lds_dwordx4 %1, %3\n\ts_mov_b32 m0, %4\n\ts_nop 0\n\tglobal_load_lds_dwordx4 %1, %5\n\ts_mov_b32 m0, %0" \
                     : "=&s"(keep_) : "v"(loff_), "s"(m0a_), "s"(rb0_), "s"(m0b_), "s"(rb1_) : "memory"); } } while (0)
    PG8_RS_DMA(cur);
    for (;;) {
        const bool has_next = S.next(ui + 1, nxt);
        const char* nA = has_next ? (const char*)g.A + (size_t)nxt.pm * tstep + (size_t)(nxt.pm >> 4) * g.padA : cA; const char* nB = has_next ? (const char*)g.Bt + (size_t)nxt.pn * tstep : cB;
        for (int t = 0; t < nt; t += 2) {
            const bool last = (t == nt - 2);
            const char* a1 = cA + (size_t)(t + 1) * kstep;
            const char* a2 = last ? nA : cA + (size_t)(t + 2) * kstep; const char* b2 = last ? nB : cB + (size_t)(t + 2) * kstep;
            const char* a3 = a2 + kstep; const char* b3 = b2 + kstep;
            PG8_LDB(B0, 0, 0); PG8_LDB(B1, 0, 1); PG8_SCHED; PG8_LDA(At, 0, 0); PG8_STAGE(PG8_SA(1, 1), a1 + hstep, voffA);
            PG8_WAIT_V(8); PG8_WAIT_L(0); PG8_BAR;
            PG8_MMA(0, 0, At, B0); PG8_MMA(0, 1, At, B1); PG8_BAR; PG8_SCHED;
            PG8_LDA(At, 0, 1); PG8_STAGE(PG8_SB(0, 0), b2, voffB); PG8_STAGE(PG8_SB(0, 1), b2 + hstep, voffB); PG8_STAGE(PG8_SA(0, 0), a2, voffA);
            PG8_WAIT_V(8); PG8_WAIT_L(0); PG8_BAR; PG8_MMA(1, 0, At, B0); PG8_MMA(1, 1, At, B1); PG8_BAR; PG8_SCHED;
            PG8_LDB(B0, 1, 0); PG8_LDB(B1, 1, 1); PG8_SCHED; PG8_LDA(At, 1, 0); PG8_STAGE(PG8_SA(0, 1), a2 + hstep, voffA);
            PG8_WAIT_V(8); PG8_WAIT_L(0); PG8_BAR; PG8_MMA(0, 0, At, B0); PG8_MMA(0, 1, At, B1); PG8_BAR; PG8_SCHED;
            PG8_LDA(At, 1, 1); PG8_STAGE(PG8_SB(1, 0), b3, voffB); PG8_STAGE(PG8_SB(1, 1), b3 + hstep, voffB); PG8_STAGE(PG8_SA(1, 0), a3, voffA);
            PG8_WAIT_V(8); PG8_WAIT_L(0); PG8_BAR; PG8_MMA(1, 0, At, B0); PG8_MMA(1, 1, At, B1); PG8_BAR; PG8_SCHED;
        }
        if constexpr (ALIGN_EPI) { if (wr == 0) PG8_BAR; }
        E(acc, cur, wr, wc, fr, fq, lds);
        if (!has_next) break;
#pragma unroll
        for (int a = 0; a < 2; ++a)
#pragma unroll
            for (int b = 0; b < 2; ++b)
#pragma unroll
                for (int m = 0; m < 4; ++m)
#pragma unroll
                    for (int n = 0; n < 2; ++n) acc[a][b][m][n] = (f32x4){0.f, 0.f, 0.f, 0.f};
        cur = nxt; cA = nA; cB = nB; ++ui;
        PG8_RS_DMA(cur);
        if constexpr (ALIGN_EPI) { if (wr == 1) PG8_BAR; }
    }
    PG8_WAIT_V(0);
    if constexpr (!ALIGN_EPI) { if (wr == 0) PG8_BAR; }
    PG8_BAR;
#undef PG8_SA
#undef PG8_SB
#undef PG8_STAGE
#undef PG8_LDA
#undef PG8_LDB
#undef PG8_MMA
#undef PG8_WAIT_V
#undef PG8_WAIT_L
#undef PG8_BAR
#undef PG8_SCHED
#undef PG8_RS_DMA
}
}

__device__ __forceinline__ unsigned f2bf(float f) { unsigned u = __builtin_bit_cast(unsigned, f); return (u + 0x7fffu + ((u >> 16) & 1u)) >> 16; }
__device__ __forceinline__ unsigned pk2(float lo, float hi) { return f2bf(lo) | (f2bf(hi) << 16); }
__device__ __forceinline__ float bf2f(bf16_t v) { return __builtin_bit_cast(float, (unsigned)v << 16); }
__device__ __forceinline__ unsigned cvtpk(float lo, float hi) { f32x2 v = {lo, hi}; bf16x2_t b = __builtin_convertvector(v, bf16x2_t); return __builtin_bit_cast(unsigned, b); }
__device__ __forceinline__ float wave_sum(float v) {
#pragma unroll
    for (int o = 1; o < 64; o <<= 1) v += __shfl_xor(v, o);
    return v;
}
__device__ __forceinline__ float wave_max(float v) {
#pragma unroll
    for (int o = 1; o < 64; o <<= 1) v = fmaxf(v, __shfl_xor(v, o));
    return v;
}
#define LDS_FENCE() asm volatile("s_waitcnt lgkmcnt(0)" ::: "memory")
#define LBAR() asm volatile("s_waitcnt lgkmcnt(0)\n\ts_barrier" ::: "memory")

struct Args { const float* in[21]; float* out; unsigned char* ws; int ph_lo, ph_hi, dup, pad; };

__device__ __forceinline__ void tr_item(const float* W, int N, int Nvalid, int nblk, bf16_t* WT, int Kp, int MAP, const float* gain, LAS float* scr, int item, int lane) {
    const int kb = item / nblk, nb = item % nblk, k0 = 64 * kb, n0 = 64 * nb;
    const int nn = n0 + lane; const bool ok = nn < Nvalid;
    float tv[64];
#pragma unroll
    for (int i = 0; i < 64; ++i) tv[i] = ok ? W[(size_t)(k0 + i) * N + nn] : 0.f;
    if (gain) {
#pragma unroll
        for (int i = 0; i < 64; ++i) tv[i] *= gain[k0 + i];
    }
#pragma unroll
    for (int i = 0; i < 64; ++i) scr[i * 65 + lane] = tv[i];
    LDS_FENCE();
    const int c = lane & 7;
    int rbase = n0; if (MAP == 1 || MAP == 2) rbase = 256 * (n0 >> 7) + (n0 & 127) + (MAP == 2 ? 128 : 0);
#pragma unroll
    for (int j = 0; j < 8; ++j) { const int n = (lane >> 3) + 8 * j; const LAS float* sp = scr + (8 * c) * 65 + n;
        u32x4 o; o.x = pk2(sp[0 * 65], sp[1 * 65]); o.y = pk2(sp[2 * 65], sp[3 * 65]); o.z = pk2(sp[4 * 65], sp[5 * 65]); o.w = pk2(sp[6 * 65], sp[7 * 65]);
        if (MAP == 3) { const int nn2 = n0 + n, kk2 = k0 + 8 * c;
            *(u32x4*)(WT + ((size_t)(((nn2 >> 4) * 64 + (kk2 >> 5)) * 64 + ((kk2 >> 3) & 3) * 16 + (nn2 & 15))) * 8) = o; }
        else *(u32x4*)(WT + (size_t)(rbase + n) * Kp + k0 + 8 * c) = o; }
    LDS_FENCE();
}
constexpr int IT_FG = (D / 64) * (FF / 64);
constexpr int IT_FD = (FF / 64) * (D / 64);
constexpr int IT_IN = (D / 64) * (NZ / 64);
constexpr int IT_OUT = (512 / 64) * (D / 64);
constexpr int IT_C1 = (2048 / 64) * (128 / 64);
constexpr int IT_C2 = (128 / 64) * (64 / 64);
constexpr int IT_LAYER = 4 * IT_FG + 2 * IT_FD + IT_IN + IT_OUT + 2 * IT_C1 + 2 * IT_C2;

__device__ __forceinline__ void prologue(const Args& a, LAS unsigned char* lds, int G) {
    int tid = threadIdx.x; asm volatile("" : "+v"(tid));
    const int lane = tid & 63, wave = __builtin_amdgcn_readfirstlane(tid >> 6);
    LAS float* scr = (LAS float*)(lds + wave * 16640);
    const int gw = blockIdx.x * NWAVES + wave, NGW = G * NWAVES;
    unsigned char* ws = a.ws;
    for (int it = gw; it < DEPTH * IT_LAYER; it += NGW) {
        const int l = it / IT_LAYER; int r = it % IT_LAYER;
        unsigned char* lw = ws + WS_W + (size_t)l * LW_STRIDE;
        const size_t oF = (size_t)l * D * FF;
        if (r < IT_FG) { tr_item(a.in[2] + oF, FF, FF, FF / 64, (bf16_t*)(lw + LW_F1), D, 1, a.in[1] + l * D, scr, r, lane); continue; } r -= IT_FG;
        if (r < IT_FG) { tr_item(a.in[3] + oF, FF, FF, FF / 64, (bf16_t*)(lw + LW_F1), D, 2, a.in[1] + l * D, scr, r, lane); continue; } r -= IT_FG;
        if (r < IT_FG) { tr_item(a.in[17] + oF, FF, FF, FF / 64, (bf16_t*)(lw + LW_F2), D, 1, a.in[16] + l * D, scr, r, lane); continue; } r -= IT_FG;
        if (r < IT_FG) { tr_item(a.in[18] + oF, FF, FF, FF / 64, (bf16_t*)(lw + LW_F2), D, 2, a.in[16] + l * D, scr, r, lane); continue; } r -= IT_FG;
        if (r < IT_FD) { tr_item(a.in[4] + oF, D, D, D / 64, (bf16_t*)(lw + LW_D1), FF, 0, nullptr, scr, r, lane); continue; } r -= IT_FD;
        if (r < IT_FD) { tr_item(a.in[19] + oF, D, D, D / 64, (bf16_t*)(lw + LW_D2), FF, 0, nullptr, scr, r, lane); continue; } r -= IT_FD;
        if (r < IT_IN) { tr_item(a.in[6] + (size_t)l * D * INW, INW, INW, NZ / 64, (bf16_t*)(lw + LW_IN), D, 0, a.in[5] + l * D, scr, r, lane); continue; } r -= IT_IN;
        if (r < IT_OUT) { tr_item(a.in[15] + (size_t)l * D * D, D, D, D / 64, (bf16_t*)(lw + LW_OUT), D, 0, nullptr, scr, r, lane); continue; } r -= IT_OUT;
        if (r < IT_C1) { tr_item(a.in[8] + (size_t)l * 2048 * 128, 128, 128, 2, (bf16_t*)(lw + LW_CK1), 2048, 3, nullptr, scr, r, lane); continue; } r -= IT_C1;
        if (r < IT_C1) { tr_item(a.in[11] + (size_t)l * 2048 * 128, 128, 128, 2, (bf16_t*)(lw + LW_CV1), 2048, 3, nullptr, scr, r, lane); continue; } r -= IT_C1;
        if (r < IT_C2) { tr_item(a.in[9] + (size_t)l * 128 * 64, 64, 64, 1, (bf16_t*)(lw + LW_CK2), 128, 0, nullptr, scr, r, lane); continue; } r -= IT_C2;
        tr_item(a.in[12] + (size_t)l * 128 * 64, 64, 64, 1, (bf16_t*)(lw + LW_CV2), 128, 0, nullptr, scr, r, lane);
    }
    const int gt = blockIdx.x * (NWAVES * 64) + tid, NGT = G * NWAVES * 64;
    for (int i = gt; i < DEPTH * 512 * (D / 4); i += NGT) {
        const int n4 = i & (D / 4 - 1), gc = (i >> 8) & 511, l = i >> 17, g = gc >> 7;
        const float* pw = a.in[13] + ((size_t)l * 512 + gc) * 128; const float* sc = a.in[14] + l * 512 + g * 128;
        const float* wo = a.in[15] + ((size_t)l * D + 512 + g * 128) * D + 4 * n4;
        f32x4 s4 = {0.f, 0.f, 0.f, 0.f};
#pragma unroll 32
        for (int d = 0; d < 128; ++d) { const f32x4 w4 = *(const f32x4*)(wo + (size_t)d * D); s4 += w4 * (pw[d] * sc[d]); }
        bf16_t* o = (bf16_t*)(ws + WS_W + (size_t)l * LW_STRIDE + LW_OUT) + 512 + gc;
#pragma unroll
        for (int j = 0; j < 4; ++j) o[(size_t)(4 * n4 + j) * D] = (bf16_t)f2bf(s4[j]);
    }
    for (int i = gw; i < DEPTH * 2 * 128; i += NGW) {
        const int j = i & 127, kv = (i >> 7) & 1, l = i >> 8;
        const float* pe = a.in[kv ? 10 : 7] + (size_t)l * 2048; const float* w1 = a.in[kv ? 11 : 8] + (size_t)l * 2048 * 128 + j;
        float s = 0.f;
#pragma unroll
        for (int k = 0; k < 32; ++k) s += pe[lane + 64 * k] * w1[(size_t)(lane + 64 * k) * 128];
        s = wave_sum(s);
        if (lane == 0) ((float*)(ws + WS_W + (size_t)l * LW_STRIDE + (kv ? LW_CBV : LW_CBK)))[j] = s;
    }
    const float* x = a.in[0]; bf16_t* xb = (bf16_t*)(ws + WS_XB); float* ssq = (float*)(ws + WS_SSQ);
    for (int m0 = gw * 4; m0 < M; m0 += NGW * 4) {
        f32x4 v[4][4]; float sq[4];
#pragma unroll
        for (int rr = 0; rr < 4; ++rr)
#pragma unroll
            for (int j = 0; j < 4; ++j) v[rr][j] = ((const f32x4*)(x + (size_t)(m0 + rr) * D) + lane)[64 * j];
#pragma unroll
        for (int rr = 0; rr < 4; ++rr) { float s = 0.f; unsigned long long* o8 = (unsigned long long*)(xb + (size_t)(m0 + rr) * D) + lane;
#pragma unroll
            for (int j = 0; j < 4; ++j) { const f32x4 w = v[rr][j]; s += (w.x * w.x + w.y * w.y) + (w.z * w.z + w.w * w.w);
                o8[64 * j] = (unsigned long long)pk2(w.x, w.y) | ((unsigned long long)pk2(w.z, w.w) << 32); }
            sq[rr] = s; }
#pragma unroll
        for (int o = 1; o < 64; o <<= 1) {
#pragma unroll
            for (int rr = 0; rr < 4; ++rr) sq[rr] += __shfl_xor(sq[rr], o); }
#pragma unroll
        for (int rr = 0; rr < 4; ++rr) if (lane < 16) ssq[(size_t)(m0 + rr) * 16 + lane] = (lane == 0) ? sq[rr] : 0.f;
    }
}

__device__ __forceinline__ void compress_phase(LAS unsigned char* lds, const bf16_t* z, const unsigned char* lw, bf16_t* kcb, int part) {
    int tid = threadIdx.x; asm volatile("" : "+v"(tid));
    const int lane = tid & 63, wid = __builtin_amdgcn_readfirstlane(tid >> 6), r = lane & 15, q4 = lane >> 4;
    LAS unsigned char* slab = lds;
    LAS bf16_t* hid = (LAS bf16_t*)(lds + 528 * 128);
    const int u0 = part >= 0 ? (((part >> 3) >> 4) << 7) | ((((part & 7) << 1) | (((part >> 3) >> 3) & 1)) << 3) | ((part >> 3) & 7) : (int)blockIdx.x;
    for (int unit = u0; unit < 256; unit += (part >= 0 ? 256 : (int)gridDim.x)) {
        const int kv = unit >> 7, bg = (unit >> 3) & 15, ct = unit & 7, b = bg >> 1, g = bg & 1;
        const bf16_t* W1f = (const bf16_t*)(lw + (kv ? LW_CV1 : LW_CK1));
        const bf16_t* W2t = (const bf16_t*)(lw + (kv ? LW_CV2 : LW_CK2));
        const float* cb = (const float*)(lw + (kv ? LW_CBV : LW_CBK));
        const bf16_t* src = z + (size_t)b * ARENA_E + (kv ? ZVC : ZKC) + g * 64;
        u32x4 sv[9];
#pragma unroll
        for (int p = 0; p < 9; ++p) { const int idx = p * 512 + tid; int tl = idx >> 3; tl = tl < 528 ? tl : 527; const int ch = idx & 7;
            int tok = 512 * ct + tl; tok = tok < T ? tok : T - 1;
            sv[p] = *(const u32x4*)(src + (size_t)tok * NZ + ch * 8); }
#pragma unroll
        for (int p = 0; p < 9; ++p) { const int idx = p * 512 + tid, tl = idx >> 3, ch = idx & 7;
            if (tl < 528) *(LAS u32x4*)(slab + tl * 128 + ((ch ^ ((tl >> 4) & 7)) * 16)) = sv[p]; }
        __syncthreads();
        f32x4 acc0 = {0.f, 0.f, 0.f, 0.f}, acc1 = {0.f, 0.f, 0.f, 0.f};
        const bf16_t* bp = W1f + ((size_t)wid * 64 * 64 + lane) * 8;
#pragma unroll 16
        for (int s = 0; s < 64; ++s) {
            const bf16x8 bv = *(const bf16x8*)(bp + (size_t)s * 512);
            const int tl0 = 16 * r + (s >> 1), chx = (((s & 1) * 4 + q4) ^ ((r + (s >> 5)) & 7)) * 16;
            const bf16x8 a0 = *(const LAS bf16x8*)(slab + tl0 * 128 + chx);
            const bf16x8 a1 = *(const LAS bf16x8*)(slab + (tl0 + 256) * 128 + chx);
            acc0 = __builtin_amdgcn_mfma_f32_16x16x32_bf16(a0, bv, acc0, 0, 0, 0);
            acc1 = __builtin_amdgcn_mfma_f32_16x16x32_bf16(a1, bv, acc1, 0, 0, 0);
        }
        const float bias = cb[16 * wid + r];
        bf16x8 w2f[4];
#pragma unroll
        for (int s2 = 0; s2 < 4; ++s2) w2f[s2] = *(const bf16x8*)(W2t + (size_t)(16 * (wid & 3) + r) * 128 + s2 * 32 + q4 * 8);
#pragma unroll
        for (int rt = 0; rt < 2; ++rt)
#pragma unroll
            for (int j = 0; j < 4; ++j) { const float xh = (rt ? acc1[j] : acc0[j]) + bias; const float y2 = 2.0f * 0.7978845608028654f * (xh + 0.044715f * xh * xh * xh);
                const float ge = xh * __builtin_amdgcn_rcpf(1.0f + __builtin_amdgcn_exp2f(-y2 * LOG2E));
                hid[(16 * rt + 4 * q4 + j) * 136 + 16 * wid + r] = (bf16_t)f2bf(ge); }
        __syncthreads();
        {
            const int rt = wid >> 2, nt = wid & 3;
            f32x4 a2 = {0.f, 0.f, 0.f, 0.f};
#pragma unroll
            for (int s = 0; s < 4; ++s) {
                const bf16x8 av = *(const LAS bf16x8*)(hid + (16 * rt + r) * 136 + s * 32 + q4 * 8);
                a2 = __builtin_amdgcn_mfma_f32_16x16x32_bf16(av, w2f[s], a2, 0, 0, 0);
            }
#pragma unroll
            for (int j = 0; j < 4; ++j) { const int cc = ct * 32 + 16 * rt + 4 * q4 + j; const float v = cc <= 254 ? a2[j] : 0.f;
                kcb[((size_t)(kv * 16 + bg) * 256 + cc) * 64 + 16 * nt + r] = (bf16_t)f2bf(v); }
        }
        __syncthreads();
    }
}

template <int W> __device__ __forceinline__ void pool_chunk(const bf16_t* up, bf16_t* op, int t0) {
    float u0[16 + W - 1], u1[16 + W - 1];
#pragma unroll
    for (int i = 0; i < 16 + W - 1; ++i) { const int t = t0 - (W - 1) + i; unsigned v = 0u; if (t >= 0) v = *(const unsigned*)(up + (size_t)t * NZ);
        u0[i] = bf2f((bf16_t)(v & 0xffff)); u1[i] = bf2f((bf16_t)(v >> 16)); }
    float s0 = 0.f, s1 = 0.f;
#pragma unroll
    for (int i = 0; i < W - 1; ++i) { s0 += u0[i]; s1 += u1[i]; }
#pragma unroll
    for (int j = 0; j < 16; ++j) { const int t = t0 + j; s0 += u0[W - 1 + j]; s1 += u1[W - 1 + j];
        const int cnt = (t + 1) < W ? (t + 1) : W; const float ic = 1.0f / (float)cnt;
        *(unsigned*)(op + (size_t)t * D) = pk2(s0 * ic - u0[W - 1 + j], s1 * ic - u1[W - 1 + j]);
        s0 -= u0[j]; s1 -= u1[j]; }
}
constexpr int POOL_TASKS = BATCH * (T / 16) * 256, POOL_ITEM_TASKS = 2 * NWAVES * 64, NPOOL = POOL_TASKS / POOL_ITEM_TASKS;
__device__ __forceinline__ void pool_item(const bf16_t* z, bf16_t* mixin, int item) {
    int tid = threadIdx.x; asm volatile("" : "+v"(tid));
    for (int task = item * POOL_ITEM_TASKS + tid; task < (item + 1) * POOL_ITEM_TASKS; task += NWAVES * 64) {
        const int cp = task & 255, chunk = task >> 8, b = chunk >> 8, t0 = (chunk & 255) * 16, gi = cp >> 6;
        const bf16_t* up = z + (size_t)b * ARENA_E + ZU + 2 * cp;
        bf16_t* op = mixin + (size_t)b * ARENA_E + 512 + 2 * cp;
        if (gi == 0) pool_chunk<2>(up, op, t0); else if (gi == 1) pool_chunk<4>(up, op, t0); else if (gi == 2) pool_chunk<8>(up, op, t0); else pool_chunk<16>(up, op, t0);
    }
}

namespace att {
__device__ __forceinline__ int crow(int r, int hi) { return (r & 3) + 8 * (r >> 2) + 4 * hi; }
__device__ __forceinline__ void qkt(f32x16& p0, f32x16& p1, const LAS unsigned char* Kslot, const bf16x8* qr, int r32, int hi, float base, float sstride) {
    const LAS unsigned char* kb = Kslot + hi * 1024 + r32 * 16;
    const float b0v = base + (float)(4 * hi) * sstride, b1v = b0v + 32.0f * sstride;
#pragma unroll
    for (int r = 0; r < 16; ++r) { const float c = (float)((r & 3) + 8 * (r >> 2)); p0[r] = __builtin_fmaf(c, sstride, b0v); p1[r] = __builtin_fmaf(c, sstride, b1v); }
    bf16x8 kf0[4], kf1[4];
#pragma unroll
    for (int d0 = 0; d0 < 4; ++d0) { kf0[d0] = *(const LAS bf16x8*)(kb + d0 * 2048); kf1[d0] = *(const LAS bf16x8*)(kb + d0 * 2048 + 512); }
    __builtin_amdgcn_s_setprio(1);
#pragma unroll
    for (int d0 = 0; d0 < 4; ++d0) {
        p0 = __builtin_amdgcn_mfma_f32_32x32x16_bf16(kf0[d0], qr[d0], p0, 0, 0, 0);
        p1 = __builtin_amdgcn_mfma_f32_32x32x16_bf16(kf1[d0], qr[d0], p1, 0, 0, 0);
    }
    __builtin_amdgcn_s_setprio(0);
}
__device__ __forceinline__ s16x4 vtr(const LAS unsigned char* p) { return __builtin_bit_cast(s16x4, __builtin_amdgcn_ds_read_tr16_b64_v4i16((LAS s16x4*)p)); }
template <bool LE> __device__ __forceinline__ void mask_kv(f32x16& p0, f32x16& p1, int lim, int hi) {
    const int l0 = lim - 4 * hi, l1 = l0 - 32;
#pragma unroll
    for (int r = 0; r < 16; ++r) { const int c = (r & 3) + 8 * (r >> 2);
        const bool k0 = LE ? (c <= l0) : (c > l0), k1 = LE ? (c <= l1) : (c > l1);
        p0[r] = k0 ? p0[r] : -INFINITY; p1[r] = k1 ? p1[r] : -INFINITY; }
}
struct Sm { float mref, l, started; f32x16 o0, o1; };
__device__ __forceinline__ void sm_init(Sm& s) { s.mref = 0.f; s.l = 0.f; s.started = 0.f;
#pragma unroll
    for (int r = 0; r < 16; ++r) { s.o0[r] = 0.f; s.o1[r] = 0.f; } }
__device__ __forceinline__ void tile_update(Sm& st, f32x16& p0, f32x16& p1, const LAS unsigned char* Vslot, LAS float* wsf, int lane, int r32, int hi) {
    float mx = fmaxf(p0[0], p1[0]);
#pragma unroll
    for (int r = 1; r < 16; ++r) mx = fmaxf(mx, fmaxf(p0[r], p1[r]));
    mx = xmax32(mx);
    const bool need = (mx > 8.0f) || (st.started == 0.f && mx > -INFINITY);
    if (__any(need)) {
        const float dl = need ? mx : 0.f;
        const float f = (st.started != 0.f) ? __builtin_amdgcn_exp2f(-dl) : 1.0f;
        st.mref += dl; st.started = need ? 1.0f : st.started;
        st.l *= f;
#pragma unroll
        for (int r = 0; r < 16; ++r) { p0[r] -= dl; p1[r] -= dl; }
        if (hi == 0) wsf[r32] = f;
        LDS_FENCE();
#pragma unroll
        for (int i = 0; i < 4; ++i) { const f32x4 fv = *(const LAS f32x4*)(wsf + 4 * hi + 8 * i);
#pragma unroll
            for (int j = 0; j < 4; ++j) { st.o0[4 * i + j] *= fv[j]; st.o1[4 * i + j] *= fv[j]; } }
        LDS_FENCE();
    }
    float rs = 0.f;
#pragma unroll
    for (int r = 0; r < 16; ++r) { p0[r] = __builtin_amdgcn_exp2f(p0[r]); p1[r] = __builtin_amdgcn_exp2f(p1[r]); rs += p0[r] + p1[r]; }
    st.l += rs;
    u32x4 pw[4];
#pragma unroll
    for (int k = 0; k < 2; ++k) { pw[k] = (u32x4){cvtpk(p0[8 * k], p0[8 * k + 1]), cvtpk(p0[8 * k + 2], p0[8 * k + 3]), cvtpk(p0[8 * k + 4], p0[8 * k + 5]), cvtpk(p0[8 * k + 6], p0[8 * k + 7])};
        pw[2 + k] = (u32x4){cvtpk(p1[8 * k], p1[8 * k + 1]), cvtpk(p1[8 * k + 2], p1[8 * k + 3]), cvtpk(p1[8 * k + 4], p1[8 * k + 5]), cvtpk(p1[8 * k + 6], p1[8 * k + 7])}; }
    const LAS unsigned char* vp = Vslot + ((lane >> 4) & 1) * 32 + (lane & 3) * 8 + (4 * hi + ((lane & 15) >> 2)) * 64;
    __builtin_amdgcn_s_setprio(1);
#pragma unroll
    for (int ks = 0; ks < 4; ++ks) {
        const bf16x8 pa = __builtin_bit_cast(bf16x8, pw[ks]);
        { const s16x4 lo = vtr(vp + ks * 1024), hh = vtr(vp + ks * 1024 + 512);
          const bf16x8 vb = {lo[0], lo[1], lo[2], lo[3], hh[0], hh[1], hh[2], hh[3]};
          st.o0 = __builtin_amdgcn_mfma_f32_32x32x16_bf16(pa, vb, st.o0, 0, 0, 0); }
        { const s16x4 lo = vtr(vp + 4096 + ks * 1024), hh = vtr(vp + 4096 + ks * 1024 + 512);
          const bf16x8 vb = {lo[0], lo[1], lo[2], lo[3], hh[0], hh[1], hh[2], hh[3]};
          st.o1 = __builtin_amdgcn_mfma_f32_32x32x16_bf16(pa, vb, st.o1, 0, 0, 0); }
    }
    __builtin_amdgcn_s_setprio(0);
}
__device__ __forceinline__ void sm_finish(Sm& st, float gate, LAS float* wsf, int r32, int hi) {
    const float lt = xadd32(st.l);
    const float fac = lt > 0.f ? gate / lt : 0.f;
    if (hi == 0) wsf[r32] = fac;
    LDS_FENCE();
#pragma unroll
    for (int i = 0; i < 4; ++i) { const f32x4 fv = *(const LAS f32x4*)(wsf + 4 * hi + 8 * i);
#pragma unroll
        for (int j = 0; j < 4; ++j) { st.o0[4 * i + j] *= fv[j]; st.o1[4 * i + j] *= fv[j]; } }
    LDS_FENCE();
}
template <bool ADD> __device__ __forceinline__ void stage_acc(const Sm& st, LAS float* stgf, int r32, int hi) {
#pragma unroll
    for (int r = 0; r < 16; ++r) { const int q = crow(r, hi);
        if (ADD) { stgf[q * 64 + r32] += st.o0[r]; stgf[q * 64 + 32 + r32] += st.o1[r]; }
        else { stgf[q * 64 + r32] = st.o0[r]; stgf[q * 64 + 32 + r32] = st.o1[r]; } }
}
__device__ __forceinline__ float dpp_x1(float v) { return __builtin_bit_cast(float, __builtin_amdgcn_mov_dpp(__builtin_bit_cast(int, v), 0xB1, 0xF, 0xF, true)); }
__device__ __forceinline__ float dpp_x2(float v) { return __builtin_bit_cast(float, __builtin_amdgcn_mov_dpp(__builtin_bit_cast(int, v), 0x4E, 0xF, 0xF, true)); }
__device__ __forceinline__ float dpp_hm(float v) { return __builtin_bit_cast(float, __builtin_amdgcn_mov_dpp(__builtin_bit_cast(int, v), 0x141, 0xF, 0xF, true)); }
__device__ __forceinline__ int dpp_ix1(int v) { return __builtin_amdgcn_mov_dpp(v, 0xB1, 0xF, 0xF, true); }
__device__ __forceinline__ int dpp_ix2(int v) { return __builtin_amdgcn_mov_dpp(v, 0x4E, 0xF, 0xF, true); }
__device__ __forceinline__ int dpp_ihm(int v) { return __builtin_amdgcn_mov_dpp(v, 0x141, 0xF, 0xF, true); }
__device__ __forceinline__ float sigmoidf(float x) { return __builtin_amdgcn_rcpf(1.0f + __builtin_amdgcn_exp2f(-x * LOG2E)); }

constexpr int L_KC = 0, L_VC = 32768, L_KS = 65536, L_VS = 81920, L_WSF = 98304, L_IMP = 100352, L_SELM = 116736, L_WUN = 117248, L_TK = 117312, L_END = 117376;

__device__ __forceinline__ void attn_unit(LAS unsigned char* lds, const bf16_t* z, const bf16_t* __restrict__ kcb, bf16_t* mixin, int b, int g, int qblk, int skip, unsigned* qhead) {
    int tid = threadIdx.x; asm volatile("" : "+v"(tid));
    const int lane = tid & 63, r32 = lane & 31, hi = lane >> 5;
    const int wid = __builtin_amdgcn_readfirstlane(tid >> 6);
    const int bg = b * 2 + g, t0 = qblk * 64, cur = qblk;
    const int ql = wid * 8 + (r32 >> 2), h = r32 & 3, head = g * 4 + h, tq = t0 + ql;
    const size_t rowb = 0; z += (size_t)b * ARENA_E; mixin += (size_t)b * ARENA_E;
    LAS float* wsf = (LAS float*)(lds + L_WSF) + wid * 64;
    LAS float* impw = (LAS float*)(lds + L_IMP) + wid * 512;
    LAS unsigned long long* selm = (LAS unsigned long long*)(lds + L_SELM);
    LAS unsigned long long* wun = (LAS unsigned long long*)(lds + L_WUN);
    const int nc = (4 * qblk + 3) < 255 ? (4 * qblk + 3) : 255; const int nct = (nc + 63) >> 6;
    u32x4 kcr[4], vcr[4];
#pragma unroll
    for (int j = 0; j < 4; ++j) if (j < nct) {
        kcr[j] = *(const u32x4*)(kcb + ((size_t)bg * 256 + 64 * j + lane) * 64 + wid * 8);
        vcr[j] = *(const u32x4*)(kcb + ((size_t)(16 + bg) * 256 + 64 * j + 16 * (wid & 3) + (lane >> 2)) * 64 + (wid >> 2) * 32 + (lane & 3) * 8); }
    bf16x8 qr[4];
    { const bf16_t* qp = z + (rowb + tq) * NZ + ZQ + head * 64 + hi * 8;
#pragma unroll
      for (int d0 = 0; d0 < 4; ++d0) qr[d0] = *(const bf16x8*)(qp + d0 * 16); }
    const bf16_t* gp = z + (rowb + tq) * NZ + ZG + head * 3;
    const float g_cmp = sigmoidf(bf2f(gp[0])), g_slc = sigmoidf(bf2f(gp[1])), g_win = sigmoidf(bf2f(gp[2]));
    const float slope2 = __builtin_amdgcn_exp2f(-(float)(head + 1)) * LOG2E;
#define ISSUE(kr, vr, d) do { const int n_ = (d) & 255; const int kc_ = ((d) & 256) ? ZKS : ZKW, vc_ = ((d) & 256) ? ZVS : ZVW; \
        kr = *(const u32x4*)(z + (rowb + 64 * n_ + lane) * NZ + kc_ + g * 64 + wid * 8); \
        vr = *(const u32x4*)(z + (rowb + 64 * n_ + 16 * (wid & 3) + (lane >> 2)) * NZ + vc_ + g * 64 + (wid >> 2) * 32 + (lane & 3) * 8); } while (0)
    const int nlo = cur >= 8 ? cur - 8 : 0;
    int dA = nlo, dB = (nlo + 1 <= cur) ? nlo + 1 : 256;
    u32x4 kA, vA, kB, vB;
    ISSUE(kA, vA, dA); ISSUE(kB, vB, dB);
#pragma unroll
    for (int j = 0; j < 4; ++j) if (j < nct) {
        *(LAS u32x4*)(lds + L_KC + j * 8192 + wid * 1024 + lane * 16) = kcr[j];
        *(LAS u32x4*)(lds + L_VC + j * 8192 + wid * 1024 + lane * 16) = vcr[j]; }
    __syncthreads();
    Sm st; sm_init(st);
    f32x16 p0, p1;
    for (int j = 0; j < nct; ++j) {
        qkt(p0, p1, lds + L_KC + j * 8192, qr, r32, hi, slope2 * (float)(1024 * j + 31 - tq) - st.mref, 16.0f * slope2);
        mask_kv<true>(p0, p1, (tq - 31 - 1024 * j) >> 4, hi);
        tile_update(st, p0, p1, lds + L_VC + j * 8192, wsf, lane, r32, hi);
    }
    sm_finish(st, g_cmp, wsf, r32, hi);
    {
        const float mc = st.mref; const float lt = xadd32(st.l); const float invl = lt > 0.f ? 1.0f / lt : 0.f;
#pragma unroll
        for (int i = 0; i < 8; ++i) impw[i * 64 + lane] = 0.f;
        LDS_FENCE();
        LAS float* irow = impw + (r32 >> 2) * 64;
        for (int j = 0; j < nct; ++j) {
            qkt(p0, p1, lds + L_KC + j * 8192, qr, r32, hi, slope2 * (float)(1024 * j + 31 - tq) - mc, 16.0f * slope2);
            mask_kv<true>(p0, p1, (tq - 31 - 1024 * j) >> 4, hi);
            float G[8], Lst[8];
#pragma unroll
            for (int i = 0; i < 4; ++i) {
                float e0 = __builtin_amdgcn_exp2f(p0[4 * i]), e1 = __builtin_amdgcn_exp2f(p0[4 * i + 1]), e2 = __builtin_amdgcn_exp2f(p0[4 * i + 2]), e3 = __builtin_amdgcn_exp2f(p0[4 * i + 3]);
                G[i] = ((e0 + e1) + (e2 + e3)) * invl; Lst[i] = e3 * invl;
                e0 = __builtin_amdgcn_exp2f(p1[4 * i]); e1 = __builtin_amdgcn_exp2f(p1[4 * i + 1]); e2 = __builtin_amdgcn_exp2f(p1[4 * i + 2]); e3 = __builtin_amdgcn_exp2f(p1[4 * i + 3]);
                G[4 + i] = ((e0 + e1) + (e2 + e3)) * invl; Lst[4 + i] = e3 * invl;
            }
#pragma unroll
            for (int i = 0; i < 8; ++i) { G[i] += dpp_x1(G[i]); G[i] += dpp_x2(G[i]); Lst[i] += dpp_x1(Lst[i]); Lst[i] += dpp_x2(Lst[i]); }
            if (h == 0) {
#pragma unroll
                for (int i = 0; i < 8; ++i) { const int n = 16 * j + (i >> 2) * 8 + 2 * (i & 3) + hi; irow[n] += G[i]; }
            }
            LDS_FENCE();
            if (h == 0) {
#pragma unroll
                for (int i = 0; i < 8; ++i) { const int n = 16 * j + (i >> 2) * 8 + 2 * (i & 3) + hi + 1; if (n < 64) irow[n] += Lst[i]; }
            }
            LDS_FENCE();
        }
        unsigned long long wm = 0ull;
        if (cur >= 8) {
            const unsigned long long forced = 1ull | (1ull << cur) | (1ull << (cur - 1));
            const int qw = lane >> 3, l8 = lane & 7;
            float v[8];
            { const f32x4 va = *(const LAS f32x4*)(impw + qw * 64 + l8 * 8), vb = *(const LAS f32x4*)(impw + qw * 64 + l8 * 8 + 4);
#pragma unroll
              for (int i = 0; i < 4; ++i) { v[i] = va[i]; v[4 + i] = vb[i]; } }
#pragma unroll
            for (int i = 0; i < 8; ++i) { const int n = l8 * 8 + i; v[i] = (n >= 1 && n <= cur - 2) ? v[i] : -1.0f; }
            unsigned long long msk = forced;
#pragma unroll 1
            for (int k = 0; k < 5; ++k) {
                float m = fmaxf(fmaxf(fmaxf(v[0], v[1]), fmaxf(v[2], v[3])), fmaxf(fmaxf(v[4], v[5]), fmaxf(v[6], v[7])));
                m = fmaxf(m, dpp_x1(m)); m = fmaxf(m, dpp_x2(m)); m = fmaxf(m, dpp_hm(m));
                int idx = 64;
#pragma unroll
                for (int i = 7; i >= 0; --i) idx = (v[i] == m) ? (l8 * 8 + i) : idx;
                idx = min(idx, dpp_ix1(idx)); idx = min(idx, dpp_ix2(idx)); idx = min(idx, dpp_ihm(idx));
                msk |= 1ull << idx;
#pragma unroll
                for (int i = 0; i < 8; ++i) v[i] = (l8 * 8 + i == idx) ? -2.0f : v[i];
            }
            if (l8 == 0) selm[wid * 8 + qw] = msk;
            wm = msk;
            wm |= __shfl_xor(wm, 8); wm |= __shfl_xor(wm, 16); wm |= __shfl_xor(wm, 32);
        } else {
            const unsigned long long msk = (1ull << (cur + 1)) - 1ull;
            if (lane < 8) selm[wid * 8 + lane] = msk;
            wm = msk;
        }
        if (lane == 0) wun[wid] = wm;
    }
    __syncthreads();
    unsigned ticket = 0u;
    if (tid == 0) ticket = __hip_atomic_fetch_add(qhead, 1u, __ATOMIC_RELAXED, __HIP_MEMORY_SCOPE_AGENT);
    unsigned long long uni = 0ull;
#pragma unroll
    for (int i = 0; i < 8; ++i) uni |= wun[i];
    const unsigned long long wmask = wun[wid];
    const unsigned long long mymask = selm[ql];
    LAS float* stgf = (LAS float*)(lds + L_KC) + wid * 2048;
    stage_acc<false>(st, stgf, r32, hi);
    {
        int wi = nlo + 2; unsigned long long rem = (dB & 256) ? (uni & ~1ull) : uni; int slot = 0; bool in_sel = false;
        sm_init(st);
#define NEXT_DESC(d) do { if (wi <= cur) { d = wi; ++wi; } else if (rem != 0ull) { d = __builtin_ctzll(rem) | 256; rem &= rem - 1ull; } else d = -1; } while (0)
#define COMMIT(kr, vr) do { *(LAS u32x4*)(lds + L_KS + slot * 8192 + wid * 1024 + lane * 16) = kr; *(LAS u32x4*)(lds + L_VS + slot * 8192 + wid * 1024 + lane * 16) = vr; } while (0)
#define COMPUTE(d) do { const int n = (d) & 255; const bool sel = ((d) & 256) != 0; \
            if (sel && !in_sel) { sm_finish(st, g_win, wsf, r32, hi); stage_acc<true>(st, stgf, r32, hi); sm_init(st); in_sel = true; } \
            if ((!sel && !(skip & 2)) || (sel && !(skip & 1) && ((wmask >> n) & 1ull))) { \
                const bool rowok = !sel || (((mymask >> n) & 1ull) != 0ull); \
                qkt(p0, p1, lds + L_KS + slot * 8192, qr, r32, hi, rowok ? slope2 * (float)(64 * n - tq) - st.mref : -INFINITY, slope2); \
                if (n == cur) mask_kv<true>(p0, p1, ql, hi); \
                else if (!sel && cur >= 8 && n == cur - 8) mask_kv<false>(p0, p1, ql, hi); \
                tile_update(st, p0, p1, lds + L_VS + slot * 8192, wsf, lane, r32, hi); } \
            slot ^= 1; } while (0)
        for (;;) {
            COMMIT(kA, vA); LBAR();
            { const int dc = dA; NEXT_DESC(dA); if (dA >= 0) ISSUE(kA, vA, dA); COMPUTE(dc); }
            if (dB < 0) break;
            COMMIT(kB, vB); LBAR();
            { const int dc = dB; NEXT_DESC(dB); if (dB >= 0) ISSUE(kB, vB, dB); COMPUTE(dc); }
            if (dA < 0) break;
        }
        sm_finish(st, g_slc, wsf, r32, hi); stage_acc<true>(st, stgf, r32, hi);
#undef NEXT_DESC
#undef COMMIT
#undef COMPUTE
    }
#undef ISSUE
    {
        LDS_FENCE();
        bf16_t* op = mixin + (rowb + t0 + wid * 8) * D + g * 256;
#pragma unroll
        for (int i = 0; i < 4; ++i) { const int piece = i * 64 + lane, tok = piece >> 5, o16 = piece & 31;
            const f32x4 v0 = *(const LAS f32x4*)(stgf + tok * 256 + o16 * 8), v1 = *(const LAS f32x4*)(stgf + tok * 256 + o16 * 8 + 4);
            u32x4 v; v.x = cvtpk(v0[0], v0[1]); v.y = cvtpk(v0[2], v0[3]); v.z = cvtpk(v1[0], v1[1]); v.w = cvtpk(v1[2], v1[3]);
            *(u32x4*)(op + (size_t)tok * D + o16 * 8) = v; }
    }
    if (tid == 0) *(LAS unsigned*)(lds + L_TK) = ticket;
    __syncthreads();
}
__device__ __forceinline__ void attn_phase(LAS unsigned char* lds, const bf16_t* z, const bf16_t* kcb, bf16_t* mixin, int skip, unsigned* qhead, bool with_pool, int part) {
    const bool per_xcd = part >= 0;
    const int bsel = part & 7;
    const unsigned n_att = per_xcd ? 128u : 1024u, n_pool = with_pool ? (per_xcd ? (unsigned)(NPOOL / BATCH) : (unsigned)NPOOL) : 0u;
    const unsigned first_dyn = per_xcd ? gridDim.x / 8u : gridDim.x;
    unsigned u = per_xcd ? (unsigned)(part >> 3) : blockIdx.x;
    while (u < n_att + n_pool) {
        if (u < n_att) {
            int b_, g_, qblk;
            if (per_xcd) { b_ = bsel; g_ = (int)(u & 1u); qblk = 63 - (int)(u >> 1); }
            else { const int bgi = (int)(u & 15u); b_ = bgi >> 1; g_ = bgi & 1; qblk = 63 - (int)(u >> 4); }
            attn_unit(lds, z, kcb, mixin, b_, g_, qblk, skip, qhead);
        } else {
            unsigned ticket = 0u;
            if (threadIdx.x == 0) ticket = __hip_atomic_fetch_add(qhead, 1u, __ATOMIC_RELAXED, __HIP_MEMORY_SCOPE_AGENT);
            pool_item(z, mixin, (int)(u - n_att) + (per_xcd ? bsel * (NPOOL / BATCH) : 0));
            if (threadIdx.x == 0) *(LAS unsigned*)(lds + L_TK) = ticket;
            __syncthreads();
        }
        const unsigned nt = *(const LAS unsigned*)(lds + L_TK);
        __syncthreads();
        u = first_dyn + nt;
    }
}
}

__device__ __forceinline__ void final_norm(const bf16_t* xb, float* out, const float* gain) {
    int tid = threadIdx.x; asm volatile("" : "+v"(tid));
    const int lane = tid & 63, wave = tid >> 6;
    const int gw = blockIdx.x * NWAVES + wave, NGW = gridDim.x * NWAVES;
    for (int m = gw; m < M; m += NGW) {
        const u32x2* xr = (const u32x2*)(xb + (size_t)m * D) + lane; f32x4* orow = (f32x4*)(out + (size_t)m * D) + lane; const f32x4* gr = (const f32x4*)gain + lane;
        f32x4 v[4]; float s = 0.f;
#pragma unroll
        for (int j = 0; j < 4; ++j) { const u32x2 pv = xr[64 * j];
            v[j] = (f32x4){__builtin_bit_cast(float, pv.x << 16), __builtin_bit_cast(float, pv.x & 0xffff0000u), __builtin_bit_cast(float, pv.y << 16), __builtin_bit_cast(float, pv.y & 0xffff0000u)};
            s += (v[j].x * v[j].x + v[j].y * v[j].y) + (v[j].z * v[j].z + v[j].w * v[j].w); }
        const float rs = 1.0f / sqrtf(wave_sum(s) * (1.0f / D) + EPS);
#pragma unroll
        for (int j = 0; j < 4; ++j) orow[64 * j] = v[j] * rs * gr[64 * j];
    }
}

#define XB_TMO      128
#define XB_XCNT(j)  (256  + 64 * (j))
#define XB_XSUB(j)  (1280 + 64 * (j))
#define XB_XGEN(j)  (2304 + 64 * (j))
#define XB_TOP      3328
#define XB_TOPGEN   3392
#define XCD_BAR_WORDS 3456
#define XB_SPIN_CAP (1u << 18)
__device__ __forceinline__ unsigned xb_ld(unsigned* p)              { return __hip_atomic_load(p, __ATOMIC_RELAXED, __HIP_MEMORY_SCOPE_AGENT); }
__device__ __forceinline__ unsigned xb_add(unsigned* p, unsigned v) { return __hip_atomic_fetch_add(p, v, __ATOMIC_RELAXED, __HIP_MEMORY_SCOPE_AGENT); }
__device__ __forceinline__ unsigned xb_xcc_id() { return (unsigned)__builtin_amdgcn_s_getreg((3 << 11) | 20) & 0xFu; }
#define XB_SPIN(cond, bar) do { unsigned _sp = 0; while (cond) { __builtin_amdgcn_s_sleep(1); \
    if ((++_sp & 255u) == 0u) { if (xb_ld(&(bar)[XB_TMO])) break; if (_sp > XB_SPIN_CAP) { atomicAdd(&(bar)[XB_TMO], 1u); break; } } } } while (0)
struct XcdBarrier { unsigned* bar; unsigned x; volatile LAS unsigned* st; };
__device__ __forceinline__ XcdBarrier xcd_barrier_post(unsigned* bar, volatile LAS unsigned* st) {
    XcdBarrier b; b.bar = bar; b.x = xb_xcc_id(); b.st = st;
    if (threadIdx.x == 0) st[2] = xb_add(&bar[XB_XCNT(b.x)], 1u);
    return b;
}
__device__ __forceinline__ void xcd_barrier_complete(unsigned* bar, unsigned x, unsigned& nloc, unsigned& nx) {
    const unsigned G = gridDim.x * gridDim.y * gridDim.z;
    unsigned sum, cnt, mine, sp = 0u;
    for (;;) {
        sum = 0u; cnt = 0u; mine = 0u;
#pragma unroll
        for (unsigned j = 0; j < 16; ++j) { const unsigned c = xb_ld(&bar[XB_XCNT(j)]); sum += c; cnt += (c > 0u) ? 1u : 0u; mine = (j == x) ? c : mine; }
        if (sum == G) break;
        __builtin_amdgcn_s_sleep(1);
        if ((++sp & 255u) == 0u) { if (xb_ld(&bar[XB_TMO])) break; if (sp > XB_SPIN_CAP) { atomicAdd(&bar[XB_TMO], 1u); break; } }
    }
    nloc = mine > 0u ? mine : 1u; nx = cnt > 0u ? cnt : 1u;
}
__device__ __forceinline__ void xcd_barrier(const XcdBarrier& b) {
    asm volatile("s_waitcnt vmcnt(0)" ::: "memory");
    __syncthreads();
    if (threadIdx.x == 0) {
        unsigned* bar = b.bar;
        __builtin_amdgcn_s_waitcnt(0);
        unsigned nloc = b.st[0], nx = b.st[1];
        if (nloc == 0u) { xcd_barrier_complete(bar, b.x, nloc, nx); b.st[0] = nloc; b.st[1] = nx; }
        const unsigned old = xb_add(&bar[XB_XSUB(b.x)], 1u);
        const unsigned gen = old / nloc;
        if (old + 1u == (gen + 1u) * nloc) {
            __builtin_amdgcn_fence(__ATOMIC_RELEASE, "agent");
            asm volatile("s_waitcnt vmcnt(0)" ::: "memory");
            const unsigned og = xb_add(&bar[XB_TOP], 1u);
            const unsigned tg = og / nx;
            if (og + 1u == (tg + 1u) * nx) xb_add(&bar[XB_TOPGEN], 1u);
            else XB_SPIN(xb_ld(&bar[XB_TOPGEN]) == tg, bar);
            __builtin_amdgcn_fence(__ATOMIC_ACQUIRE, "agent");
            xb_add(&bar[XB_XGEN(b.x)], 1u);
            asm volatile("s_waitcnt vmcnt(0)" ::: "memory");
        } else {
            XB_SPIN(xb_ld(&bar[XB_XGEN(b.x)]) == gen, bar);
            __builtin_amdgcn_fence(__ATOMIC_ACQUIRE, "agent");
            asm volatile("s_waitcnt vmcnt(0)" ::: "memory");
        }
    }
    __syncthreads();
}

__device__ __forceinline__ void xcd_barrier_local(const XcdBarrier& b) {
    asm volatile("s_waitcnt vmcnt(0)" ::: "memory");
    __syncthreads();
    if (threadIdx.x == 0) {
        unsigned* bar = b.bar;
        __builtin_amdgcn_s_waitcnt(0);
        const unsigned nloc = b.st[0];
        const unsigned old = xb_add(&bar[XB_XSUB(b.x)], 1u);
        const unsigned gen = old / nloc;
        if (old + 1u == (gen + 1u) * nloc) xb_add(&bar[XB_XGEN(b.x)], 1u);
        else XB_SPIN(xb_ld(&bar[XB_XGEN(b.x)]) == gen, bar);
        __builtin_amdgcn_fence(__ATOMIC_ACQUIRE, "agent");
        asm volatile("s_waitcnt vmcnt(0)" ::: "memory");
    }
    __syncthreads();
}
__device__ __forceinline__ void xcd_virtual_id(const XcdBarrier& b, int& vid, bool& local_ok) {
    if (threadIdx.x == 0) {
        const unsigned G = gridDim.x; bool ok = (G % 8u) == 0u;
#pragma unroll
        for (unsigned j = 0; j < 16; ++j) { const unsigned c = xb_ld(&b.bar[XB_XCNT(j)]); ok = ok && (c == (j < 8u ? G / 8u : 0u)); }
        ok = ok && b.x < 8u && b.st[2] < G / 8u && xb_ld(&b.bar[XB_TMO]) == 0u;
        b.st[3] = ok ? 1u : 0u; if (ok) b.st[2] = b.st[2] * 8u + b.x; else b.st[2] = blockIdx.x;
    }
    __syncthreads();
    vid = __builtin_amdgcn_readfirstlane((int)b.st[2]); local_ok = __builtin_amdgcn_readfirstlane((int)b.st[3]) != 0;
    __syncthreads();
}

constexpr int LDS_BYTES = 147456 + 256;
constexpr int N_PHASES = 2 + 8 * DEPTH;

__global__ void __launch_bounds__(NWAVES * 64, 2) fwd_kernel(Args args) {
    extern __shared__ __attribute__((aligned(16))) unsigned char lds_raw[];
    LAS unsigned char* lds = (LAS unsigned char*)lds_raw;
    cg::grid_group grid = cg::this_grid();
    const int G = gridDim.x;
    unsigned char* ws = args.ws;
    float* xres = args.out;
    float* ssq = (float*)(ws + WS_SSQ);
    bf16_t* xb = (bf16_t*)(ws + WS_XB);
    bf16_t* act = (bf16_t*)(ws + WS_BIG);
    bf16_t* zb = (bf16_t*)(ws + WS_Z);
    bf16_t* mixin = (bf16_t*)(ws + WS_MIX);
    bf16_t* kcb = (bf16_t*)(ws + WS_KC);
    unsigned* barw = (unsigned*)(ws + WS_CTL);
    volatile LAS unsigned* bst = (volatile LAS unsigned*)(lds + LDS_BYTES - 64)      ;
    if (threadIdx.x < 4) bst[threadIdx.x] = 0u;
    __syncthreads();
    XcdBarrier xbar; xbar.bar = barw; xbar.x = 0; xbar.st = bst;
#ifndef DUPMASK
#define DUPMASK 0
#endif
    int ph = args.ph_lo; const int hi_ph = args.ph_hi;
    int vid = (int)blockIdx.x; bool local_ok = false;
    if (args.ph_lo < 0) grid.sync();
    if (hi_ph - ph > 1) xbar = xcd_barrier_post(barw, bst);
    if (ph == 0) {
        prologue(args, lds, G);
        if (args.dup & 8192) { __syncthreads(); prologue(args, lds, G); }
        ph = 1;
        if (ph < hi_ph) { xcd_barrier(xbar); xcd_virtual_id(xbar, vid, local_ok); }
    }
    bool need_bar = false;
    for (; ph < hi_ph && ph < N_PHASES - 1; ++ph) {
        const int l = (ph - 1) >> 3, k = (ph - 1) & 7;
        if (need_bar) { if (local_ok && args.dup == 0) xcd_barrier_local(xbar); else { xcd_barrier(xbar); if (args.dup & 1024) xcd_barrier(xbar); } }
        need_bar = true;
        const unsigned char* lw = ws + WS_W + (size_t)l * LW_STRIDE;
        const int reps = ((args.dup >> k) & 1) ? 2 : 1;
        for (int rep = 0; rep < reps; ++rep) {
        pg8::StaticOrder S;
        if (k == 0 || k == 6) {
            pg8::Gemm g{xb, (const bf16_t*)(lw + (k == 0 ? LW_F1 : LW_F2)), M, 2 * FF, D, 0}; S.init(M, 2 * FF, G, vid);
            pg8::EpiSwiGLU E{act, ssq};
            pg8::gemm_phase<pg8::EpiSwiGLU>(lds, g, S, E);
        } else if (k == 1 || k == 7) {
            pg8::Gemm g{act, (const bf16_t*)(lw + (k == 1 ? LW_D1 : LW_D2)), M, D, FF, PAD_ACT * 2}; S.init(M, D, G, vid);
            pg8::EpiResid E{xb, ssq, rep == 0 ? 0.5f : 0.0f};
            pg8::gemm_phase<pg8::EpiResid>(lds, g, S, E);
        } else if (k == 2) {
            pg8::Gemm g{xb, (const bf16_t*)(lw + LW_IN), M, NZ, D, 0}; S.init(M, NZ, G, vid);
            pg8::EpiZ E{zb, ssq};
            pg8::gemm_phase<pg8::EpiZ>(lds, g, S, E);
        } else if (k == 3) {
            compress_phase(lds, zb, lw, kcb, local_ok ? vid : -1);
        } else if (k == 4) {
            if (rep == 0 || (args.dup & 512)) att::attn_phase(lds, zb, kcb, mixin, (reps > 1 && rep == 0) ? ((args.dup >> 11) & 3) : 0, barw + XCD_BAR_WORDS + ((l * 2 + rep) * 8 + (local_ok ? (vid & 7) : 0)) * 64, rep == 0 || (args.dup & 256), local_ok ? vid : -1);
        } else {
            pg8::Gemm g{mixin, (const bf16_t*)(lw + LW_OUT), M, D, D, PAD_MIX * 2}; S.init(M, D, G, vid);
            pg8::EpiResid E{xb, ssq, rep == 0 ? 1.0f : 0.0f};
            pg8::gemm_phase<pg8::EpiResid>(lds, g, S, E);
        }
        if (reps > 1 && rep == 0) xcd_barrier(xbar);
        }
    }
    if (ph < hi_ph) { if (need_bar) xcd_barrier(xbar); final_norm(xb, xres, args.in[20]); }
}

#ifndef MK_MULTI
#define MK_MULTI 0
#endif
extern "C" void kernel_launch(void* const* d_in, const int* in_sizes, int n_in, void* d_out, int out_size, void* d_ws, size_t ws_size, hipStream_t stream) {
    static int grid = 0;
    if (grid == 0) {
        if (n_in != 21 || in_sizes[0] != M * D || out_size != M * D || ws_size < WS_END) {
            fprintf(stderr, "kernel_launch: unexpected problem: n_in %d in0 %d out %d ws %zu (need %zu)\n", n_in, n_in > 0 ? in_sizes[0] : -1, out_size, ws_size, (size_t)WS_END); grid = -1; return; }
        int dev = 0, cus = 0, per_cu = 0;
        hipGetDevice(&dev);
        hipDeviceGetAttribute(&cus, hipDeviceAttributeMultiprocessorCount, dev);
        if (hipFuncSetAttribute((const void*)fwd_kernel, hipFuncAttributeMaxDynamicSharedMemorySize, LDS_BYTES) != hipSuccess) { fprintf(stderr, "kernel_launch: hipFuncSetAttribute failed\n"); grid = -1; return; }
        if (hipOccupancyMaxActiveBlocksPerMultiprocessor(&per_cu, (const void*)fwd_kernel, NWAVES * 64, LDS_BYTES) != hipSuccess || per_cu < 1) { fprintf(stderr, "kernel_launch: occupancy query says %d\n", per_cu); per_cu = 1; }
        (void)hipGetLastError();
        if (per_cu > 1) per_cu = 1;
        grid = cus * per_cu;
        fprintf(stderr, "kernel_launch: grid %d (cus %d x %d)\n", grid, cus, per_cu);
    }
    if (grid < 0) return;
    if (hipMemsetAsync((char*)d_ws + WS_CTL, 0, CTL_ZERO_BYTES, stream) != hipSuccess) { fprintf(stderr, "kernel_launch: hipMemsetAsync of the control words failed\n"); return; }
    Args a{};
    for (int i = 0; i < 21; ++i) a.in[i] = (const float*)d_in[i];
    a.out = (float*)d_out; a.ws = (unsigned char*)d_ws; a.dup = DUPMASK;
#if MK_MULTI
    for (int ph = 0; ph < N_PHASES; ++ph) { a.ph_lo = ph; a.ph_hi = ph + 1; hipLaunchKernelGGL(fwd_kernel, dim3(grid), dim3(NWAVES * 64), LDS_BYTES, stream, a); }
#else
    a.ph_lo = 0; a.ph_hi = N_PHASES;
    void* kargs[] = {&a};
    hipError_t e = hipLaunchCooperativeKernel((const void*)fwd_kernel, dim3(grid), dim3(NWAVES * 64), kargs, LDS_BYTES, stream);
    if (e != hipSuccess) fprintf(stderr, "kernel_launch: cooperative launch failed: %s (grid %d)\n", hipGetErrorString(e), grid);
#endif
}
```
